# Optimizing an MI355X kernel written in HIP

```python
import jax, jax.numpy as jnp
from jax import lax
import numpy as np

D_MODEL = 1024
BATCH = 16
SEQ = 4096
DEPTH = 1

N_META = 16
HEAD_DIM = 64
N_HEADS = D_MODEL // HEAD_DIM
N_KV_HEADS = N_HEADS // 4
GQA_GROUP = N_HEADS // N_KV_HEADS
WINDOW = 128
ATTN_BLOCK = 128
ROPE_THETA = 500000.0
ROPE_DIM = HEAD_DIM // 4
ML_HEADS = 4
ML_V_DIM = D_MODEL // ML_HEADS
ML_QK_DIM = ML_V_DIM // 2
ML_CHUNK = 64
CONV_WIDTH = 4
RMS_EPS = 1e-6
LN_EPS = 1e-6
NEG_BIG = -1e30

ATTN_WIDTH = N_HEADS * HEAD_DIM
KV_WIDTH = N_KV_HEADS * HEAD_DIM
ML_QK_WIDTH = ML_HEADS * ML_QK_DIM
ML_WIDTH = ML_HEADS * ML_V_DIM
SPLIT_SIZES = (ATTN_WIDTH, KV_WIDTH, KV_WIDTH, ATTN_WIDTH,
               2 * ML_QK_WIDTH, ML_WIDTH, ML_HEADS, ML_HEADS, ML_WIDTH, ML_WIDTH,
               D_MODEL, D_MODEL)
IN_WIDTH = sum(SPLIT_SIZES)
SPLIT_POINTS = tuple(int(c) for c in np.cumsum(SPLIT_SIZES)[:-1])

kernel_name = "hybrid_swa_sink_mlstm_gated_merge"


def _rmsnorm(x, g):
    xf = x.astype(jnp.float32)
    y = xf * lax.rsqrt(jnp.mean(xf * xf, axis=-1, keepdims=True) + RMS_EPS)
    return (y * g.astype(jnp.float32)).astype(x.dtype)


def _partial_rope(t, pos):
    half = ROPE_DIM // 2
    inv_freq = ROPE_THETA ** (-jnp.arange(0, ROPE_DIM, 2, dtype=jnp.float32) / ROPE_DIM)
    ang = pos[:, None] * inv_freq[None, :]
    cos = jnp.cos(ang)[None, :, None, :]
    sin = jnp.sin(ang)[None, :, None, :]
    tf = t.astype(jnp.float32)
    t1, t2, rest = tf[..., :half], tf[..., half:ROPE_DIM], tf[..., ROPE_DIM:]
    out = jnp.concatenate([t1 * cos - t2 * sin, t2 * cos + t1 * sin, rest], axis=-1)
    return out.astype(t.dtype)


def _sink_attention(q, k, v, mask, sink):
    s = jnp.einsum('bqhgd,bkhd->bhgqk', q, k).astype(jnp.float32)
    s = jnp.where(mask, s, NEG_BIG)
    sink_b = sink.astype(jnp.float32)[None, :, :, None, None]
    mx = jnp.maximum(jnp.max(s, axis=-1, keepdims=True), sink_b)
    p = jnp.exp(s - mx)
    denom = jnp.sum(p, axis=-1, keepdims=True) + jnp.exp(sink_b - mx)
    p = (p / denom).astype(v.dtype)
    return jnp.einsum('bhgqk,bkhd->bqhgd', p, v)


def _swa_sink_branch(q, k, v, sinks):
    B, L = q.shape[0], q.shape[1]
    S = L - N_META
    NB = S // ATTN_BLOCK
    pos = jnp.arange(L, dtype=jnp.float32)
    q = _partial_rope(q, pos) * (HEAD_DIM ** -0.5)
    k = _partial_rope(k, pos)
    q = q.reshape(B, L, N_KV_HEADS, GQA_GROUP, HEAD_DIM)
    sink = sinks.reshape(N_KV_HEADS, GQA_GROUP)
    qm, km, vm = q[:, :N_META], k[:, :N_META], v[:, :N_META]
    meta_mask = jnp.tril(jnp.ones((N_META, N_META), dtype=bool))
    out_meta = _sink_attention(qm, km, vm, meta_mask, sink)

    def blocks(t):
        return t[:, N_META:].reshape((B, NB, ATTN_BLOCK) + t.shape[2:])

    qb, kb, vb = blocks(q), blocks(k), blocks(v)

    def band_keys(tb, tm):
        prev = jnp.concatenate([jnp.zeros_like(tb[:, :1]), tb[:, :-1]], axis=1)
        meta = jnp.broadcast_to(tm[:, None], (B, NB) + tm.shape[1:])
        return jnp.concatenate([meta, prev, tb], axis=2).swapaxes(0, 1)

    kband, vband = band_keys(kb, km), band_keys(vb, vm)
    qi = jnp.arange(ATTN_BLOCK)[:, None]
    kj = jnp.arange(2 * ATTN_BLOCK)[None, :]
    rel = qi + ATTN_BLOCK - kj
    blk = jnp.arange(NB)[:, None, None]
    local = (rel >= 0) & (rel < WINDOW) & (blk * ATTN_BLOCK + kj - ATTN_BLOCK >= 0)
    mask = jnp.concatenate([jnp.ones((NB, ATTN_BLOCK, N_META), dtype=bool), local], axis=-1)
    out_blocks = lax.map(lambda a: _sink_attention(a[0], a[1], a[2], a[3], sink),
                         (qb.swapaxes(0, 1), kband, vband, mask))
    out_real = out_blocks.swapaxes(0, 1).reshape(B, S, ATTN_WIDTH)
    return jnp.concatenate([out_meta.reshape(B, N_META, ATTN_WIDTH), out_real], axis=1)


def _causal_conv(t, w, b):
    out = lax.conv_general_dilated(
        t, w[:, None, :].astype(t.dtype), window_strides=(1,),
        padding=((CONV_WIDTH - 1, 0),), dimension_numbers=('NWC', 'WIO', 'NWC'),
        feature_group_count=t.shape[-1])
    return out + b.astype(t.dtype)


def _mlstm_cell(q, k, v, i_pre, f_pre):
    B, L = q.shape[0], q.shape[1]
    f32 = jnp.float32
    pad = (-N_META) % ML_CHUNK
    q = q.astype(f32)
    k = k.astype(f32) * (ML_QK_DIM ** -0.5)
    v = v.astype(f32)
    li = i_pre.astype(f32)
    lf = jax.nn.log_sigmoid(f_pre.astype(f32))

    def padt(t, val):
        return jnp.pad(t, ((0, 0), (pad, 0)) + ((0, 0),) * (t.ndim - 2), constant_values=val)

    q, k, v, lf = padt(q, 0.0), padt(k, 0.0), padt(v, 0.0), padt(lf, 0.0)
    li = padt(li, NEG_BIG)
    NC = (L + pad) // ML_CHUNK

    def chunks(t):
        t = t.reshape((B, NC, ML_CHUNK) + t.shape[2:])
        return t.transpose((1, 0, 3, 2) + tuple(range(4, t.ndim)))

    xs = (chunks(q), chunks(k), chunks(v), chunks(li), chunks(lf))
    causal = jnp.tril(jnp.ones((ML_CHUNK, ML_CHUNK), dtype=bool))

    def body(carry, inp):
        C, n, m = carry
        qc, kc, vc, lic, lfc = inp
        bcum = jnp.cumsum(lfc, axis=-1)
        Dm = jnp.where(causal, bcum[..., :, None] - bcum[..., None, :] + lic[..., None, :], NEG_BIG)
        inter = bcum + m[..., None]
        m_row = jnp.maximum(inter, jnp.max(Dm, axis=-1))
        w_inter = jnp.exp(inter - m_row)
        sc = jnp.einsum('bhtd,bhsd->bhts', qc, kc) * jnp.exp(Dm - m_row[..., None])
        num = w_inter[..., None] * jnp.einsum('bhtd,bhvd->bhtv', qc, C) + jnp.einsum('bhts,bhsv->bhtv', sc, vc)
        den = w_inter * jnp.einsum('bhtd,bhd->bht', qc, n) + jnp.sum(sc, axis=-1)
        h = num / jnp.maximum(jnp.abs(den), jnp.exp(-m_row))[..., None]
        b_last = bcum[..., -1]
        a = b_last[..., None] - bcum + lic
        m_new = jnp.maximum(b_last + m, jnp.max(a, axis=-1))
        w_c = jnp.exp(b_last + m - m_new)
        w_a = jnp.exp(a - m_new[..., None])
        C = w_c[..., None, None] * C + jnp.einsum('bhs,bhsv,bhsd->bhvd', w_a, vc, kc)
        n = w_c[..., None] * n + jnp.einsum('bhs,bhsd->bhd', w_a, kc)
        return (C, n, m_new), h

    init = (jnp.zeros((B, ML_HEADS, ML_V_DIM, ML_QK_DIM), f32),
            jnp.zeros((B, ML_HEADS, ML_QK_DIM), f32),
            jnp.zeros((B, ML_HEADS), f32))
    _, hs = lax.scan(body, init, xs)
    hs = hs.transpose(1, 0, 3, 2, 4).reshape(B, NC * ML_CHUNK, ML_HEADS, ML_V_DIM)
    return hs[:, pad:]


def _head_layernorm(h, g):
    mu = jnp.mean(h, axis=-1, keepdims=True)
    hc = h - mu
    y = hc * lax.rsqrt(jnp.mean(hc * hc, axis=-1, keepdims=True) + LN_EPS)
    y = y * g.astype(jnp.float32).reshape(ML_HEADS, ML_V_DIM)
    return y.reshape(h.shape[0], h.shape[1], ML_WIDTH)


def _hybrid_mixer(u, w_in, attn_sinks, conv_w, conv_b, gate_bias, head_norm,
                  w_attn_out, w_mlstm_out, w_out):
    B, L, _ = u.shape
    proj = u @ w_in.astype(u.dtype)
    (a_q, a_k, a_v, a_z, m_qk, m_v, m_i, m_f, m_o, m_z, g_a, g_m) = jnp.split(proj, SPLIT_POINTS, axis=-1)
    att = _swa_sink_branch(a_q.reshape(B, L, N_HEADS, HEAD_DIM),
                           a_k.reshape(B, L, N_KV_HEADS, HEAD_DIM),
                           a_v.reshape(B, L, N_KV_HEADS, HEAD_DIM), attn_sinks)
    y_a = (att * jax.nn.silu(a_z)) @ w_attn_out.astype(u.dtype)
    m_qk = jax.nn.silu(_causal_conv(m_qk, conv_w, conv_b))
    m_q, m_k = jnp.split(m_qk, 2, axis=-1)
    cell = _mlstm_cell(m_q.reshape(B, L, ML_HEADS, ML_QK_DIM),
                       m_k.reshape(B, L, ML_HEADS, ML_QK_DIM),
                       m_v.reshape(B, L, ML_HEADS, ML_V_DIM),
                       m_i + gate_bias[:ML_HEADS].astype(u.dtype),
                       m_f + gate_bias[ML_HEADS:].astype(u.dtype))
    o_gate = jax.nn.sigmoid(m_o.astype(jnp.float32)).reshape(B, L, ML_HEADS, ML_V_DIM)
    hm = _head_layernorm(o_gate * cell, head_norm).astype(u.dtype)
    y_m = (hm * jax.nn.silu(m_z)) @ w_mlstm_out.astype(u.dtype)
    merged = jax.nn.sigmoid(g_a) * y_a + jax.nn.sigmoid(g_m) * y_m
    return merged @ w_out.astype(u.dtype)


def setup_inputs(seed: int = 0) -> dict:
    key = jax.random.key(seed)
    ks = jax.random.split(key, 16)
    nrm = jax.random.normal
    x = nrm(ks[0], (BATCH, SEQ, D_MODEL), jnp.float32)
    meta_tokens = nrm(ks[1], (N_META, D_MODEL), jnp.float32)
    norm_pre = 1.0 + 0.01 * nrm(ks[2], (DEPTH, D_MODEL), jnp.float32)
    w_in = nrm(ks[3], (DEPTH, D_MODEL, IN_WIDTH), jnp.float32) * D_MODEL ** -0.5
    attn_sinks = 0.5 * nrm(ks[4], (DEPTH, N_HEADS), jnp.float32)
    conv_w = nrm(ks[5], (DEPTH, CONV_WIDTH, 2 * ML_QK_WIDTH), jnp.float32) * CONV_WIDTH ** -0.5
    conv_b = 0.01 * nrm(ks[6], (DEPTH, 2 * ML_QK_WIDTH), jnp.float32)
    i_bias = 0.1 * nrm(ks[7], (DEPTH, ML_HEADS), jnp.float32)
    f_bias = 3.0 + 3.0 * jax.random.uniform(ks[8], (DEPTH, ML_HEADS), jnp.float32)
    mlstm_gate_bias = jnp.concatenate([i_bias, f_bias], axis=-1)
    mlstm_head_norm = 1.0 + 0.01 * nrm(ks[9], (DEPTH, ML_WIDTH), jnp.float32)
    w_attn_out = nrm(ks[10], (DEPTH, ATTN_WIDTH, D_MODEL), jnp.float32) * ATTN_WIDTH ** -0.5
    w_mlstm_out = nrm(ks[11], (DEPTH, ML_WIDTH, D_MODEL), jnp.float32) * ML_WIDTH ** -0.5
    w_out = nrm(ks[12], (DEPTH, D_MODEL, D_MODEL), jnp.float32) * D_MODEL ** -0.5
    norm_post = 1.0 + 0.01 * nrm(ks[13], (DEPTH, D_MODEL), jnp.float32)
    return {"x": x, "meta_tokens": meta_tokens, "norm_pre": norm_pre, "w_in": w_in,
            "attn_sinks": attn_sinks, "conv_w": conv_w, "conv_b": conv_b,
            "mlstm_gate_bias": mlstm_gate_bias, "mlstm_head_norm": mlstm_head_norm,
            "w_attn_out": w_attn_out, "w_mlstm_out": w_mlstm_out, "w_out": w_out,
            "norm_post": norm_post}


def reference(x, meta_tokens, norm_pre, w_in, attn_sinks, conv_w, conv_b, mlstm_gate_bias,
              mlstm_head_norm, w_attn_out, w_mlstm_out, w_out, norm_post):
    B = x.shape[0]
    meta = jnp.broadcast_to(meta_tokens.astype(x.dtype)[None], (B,) + meta_tokens.shape)
    h = jnp.concatenate([meta, x], axis=1)
    for layer in range(DEPTH):
        u = _rmsnorm(h, norm_pre[layer])
        y = _hybrid_mixer(u, w_in[layer], attn_sinks[layer], conv_w[layer], conv_b[layer],
                          mlstm_gate_bias[layer], mlstm_head_norm[layer],
                          w_attn_out[layer], w_mlstm_out[layer], w_out[layer])
        h = h + _rmsnorm(y, norm_post[layer])
    return h[:, N_META:]
```

```cpp
#include <hip/hip_runtime.h>
#include <cstdio>
#include <cstdint>
#ifndef MK_ONE_LAUNCH
#define MK_ONE_LAUNCH 0
#endif
namespace pg8 {
#define PG8_LAS __attribute__((address_space(3)))
typedef unsigned short bf16_t;
typedef short bf16x8 __attribute__((ext_vector_type(8)));
typedef float f32x4 __attribute__((ext_vector_type(4)));
typedef unsigned u32x4 __attribute__((ext_vector_type(4)));
constexpr int BM = 256, BK = 64, HALF = 128, HTB = HALF * BK * 2  , STAGE_BYTES = 8 * HTB, NXCD = 8, WGM = 8;

__host__ __device__ __forceinline__ int lds_byte(int r, int c) { const int st = (r >> 4) * 2 + (c >> 5), rr = r & 15, cc = c & 31, ob = rr * 64 + cc * 2; return st * 1024 + (ob ^ (((ob >> 9) & 1) << 5)); }
__host__ __device__ __forceinline__ void stage_rc(int b, int& R, int& C) { const int st = b / 1024, sb = b % 1024, swz = sb ^ (((sb >> 9) & 1) << 5); R = (st >> 1) * 16 + swz / 64; C = (st & 1) * 32 + (swz % 64) / 2; }
__host__ __device__ __forceinline__ int perm32(int rho) { const int n = rho >> 4, i = rho & 15; return 8 * (i >> 2) + 4 * n + (i & 3); }

struct Unit { int pm, pn; };
struct Gemm { const bf16_t* A; const bf16_t* Bt; int M, N, K; };

struct StaticOrder {
    int nM, nN, nwg, G, c;
    __host__ __device__ void init(int M, int N, int G_, int c_) { nM = M / BM; nN = N / BM; nwg = nM * nN; G = G_; c = c_; }
    __host__ __device__ bool next(int i, Unit& u) const {
        const long L = (long)i * G + c; if (L >= nwg) return false;
        int wgid = (int)L; { const int q = nwg / NXCD, r = nwg % NXCD, xcd = wgid % NXCD, off = wgid / NXCD; wgid = (xcd < r ? xcd * (q + 1) : r * (q + 1) + (xcd - r) * q) + off; }
        const int nig = WGM * nN, gid = wgid / nig, fm = gid * WGM, gsz = (nM - fm) < WGM ? (nM - fm) : WGM;
        u.pm = fm + ((wgid % nig) % gsz); u.pn = (wgid % nig) / gsz; return true;
    }
    __device__ __forceinline__ void a_ready(const Unit&) const {}
    __device__ __forceinline__ void done(const Unit&) const {}
};

__device__ __forceinline__ unsigned cvt_pk_bf16(float lo, float hi) { unsigned r; asm volatile("v_cvt_pk_bf16_f32 %0, %1, %2" : "=v"(r) : "v"(lo), "v"(hi)); return r; }
__device__ __forceinline__ float bflo(unsigned w) { return __uint_as_float(w << 16); }
__device__ __forceinline__ float bfhi(unsigned w) { return __uint_as_float(w & 0xffff0000u); }
__device__ __forceinline__ float sigmoidf_(float x) { return 1.0f / (1.0f + __expf(-x)); }
__device__ __forceinline__ float siluf_(float x) { return x / (1.0f + __expf(-x)); }

constexpr int ROWS_REAL = 65536;

struct EpiInProj {
    static constexpr bool PERM = true, AFTER_DRAIN = false;
    unsigned char* ws; unsigned char* dout; const float* rope;
    __device__ __forceinline__ void operator()(const f32x4 (&acc)[2][2][4][2], const Unit& u, int wr, int wc, int fr, int fq) const {
        const int pn = u.pn; size_t boff; int ldc = 1024, colt, act; bool meta = false;
        constexpr size_t MB = 1u << 20;
        if (pn < 4)       { boff = 484 * MB; colt = pn * 256;        act = 4; }
        else if (pn == 4) { boff = 161 * MB; colt = 0;   ldc = 512;  act = 3; meta = true; }
        else if (pn == 5) { boff = 161 * MB; colt = 256; ldc = 512;  act = 0; meta = true; }
        else if (pn < 10) { boff = 612 * MB; colt = (pn - 6) * 256;  act = 1; }
        else if (pn < 14) { boff = 226 * MB; colt = (pn - 10) * 256; act = 0; meta = true; }
        else if (pn < 18) { boff = 355 * MB; colt = (pn - 14) * 256; act = 0; meta = true; }
        else if (pn < 22) { boff = 740 * MB; colt = (pn - 18) * 256; act = 2; }
        else if (pn < 26) { boff = 868 * MB; colt = (pn - 22) * 256; act = 1; }
        else if (pn < 30) { boff = 0;        colt = (pn - 26) * 256; act = 2; }
        else              { boff = 128 * MB; colt = (pn - 30) * 256; act = 2; }
        bf16_t* base = (bf16_t*)((pn >= 26 ? dout : ws) + boff);
        if (u.pm == 256 && !meta) return;
        const int row0 = u.pm * BM + wr * 64 + fr, col0 = colt + wc * 32 + 8 * fq;
        const bool ropel = ((wc & 1) == 0) && (fq < 2);
#pragma unroll
        for (int ai = 0; ai < 2; ++ai)
#pragma unroll
            for (int m = 0; m < 4; ++m) {
                const int row = row0 + ai * HALF + m * 16;
                bf16_t* rowp = base + (size_t)row * ldc + col0;
                f32x4 cs0, cs1, sn0, sn1;
                if (act >= 3) { const int pos = (u.pm == 256) ? (row - ROWS_REAL) : 16 + (row & 4095); const float* rp = rope + (size_t)pos * 16;
                    cs0 = *(const f32x4*)(rp); cs1 = *(const f32x4*)(rp + 4); sn0 = *(const f32x4*)(rp + 8); sn1 = *(const f32x4*)(rp + 12); }
#pragma unroll
                for (int bj = 0; bj < 2; ++bj) {
                    f32x4 v0 = acc[ai][bj][m][0], v1 = acc[ai][bj][m][1];
                    if (act == 1) {
#pragma unroll
                        for (int e = 0; e < 4; ++e) { v0[e] = siluf_(v0[e]); v1[e] = siluf_(v1[e]); }
                    } else if (act == 2) {
#pragma unroll
                        for (int e = 0; e < 4; ++e) { v0[e] = sigmoidf_(v0[e]); v1[e] = sigmoidf_(v1[e]); }
                    } else if (act >= 3) {
                        f32x4 p0, p1;
#pragma unroll
                        for (int e = 0; e < 4; ++e) { p0[e] = __shfl_xor(v0[e], 16); p1[e] = __shfl_xor(v1[e], 16); }
                        if (ropel) {
                            if (fq == 0) { v0 = v0 * cs0 - p0 * sn0; v1 = v1 * cs1 - p1 * sn1; }
                            else         { v0 = v0 * cs0 + p0 * sn0; v1 = v1 * cs1 + p1 * sn1; }
                        }
                        if (act == 4) { v0 = v0 * 0.125f; v1 = v1 * 0.125f; }
                    }
                    u32x4 w; w.x = cvt_pk_bf16(v0[0], v0[1]); w.y = cvt_pk_bf16(v0[2], v0[3]); w.z = cvt_pk_bf16(v1[0], v1[1]); w.w = cvt_pk_bf16(v1[2], v1[3]);
                    *(u32x4*)(rowp + bj * HALF) = w;
                }
            }
    }
};
struct EpiGate {
    static constexpr bool PERM = true, AFTER_DRAIN = false;
    const bf16_t* G; const bf16_t* T; bf16_t* O;
    __device__ __forceinline__ void operator()(const f32x4 (&acc)[2][2][4][2], const Unit& u, int wr, int wc, int fr, int fq) const {
        const int row0 = u.pm * BM + wr * 64 + fr, col0 = u.pn * BM + wc * 32 + 8 * fq;
#pragma unroll
        for (int ai = 0; ai < 2; ++ai)
#pragma unroll
            for (int m = 0; m < 4; ++m) { const size_t off = (size_t)(row0 + ai * HALF + m * 16) * 1024 + col0;
#pragma unroll
                for (int bj = 0; bj < 2; ++bj) {
                    const u32x4 g = *(const u32x4*)(G + off + bj * HALF);
                    f32x4 v0 = acc[ai][bj][m][0], v1 = acc[ai][bj][m][1];
                    v0[0] *= bflo(g.x); v0[1] *= bfhi(g.x); v0[2] *= bflo(g.y); v0[3] *= bfhi(g.y);
                    v1[0] *= bflo(g.z); v1[1] *= bfhi(g.z); v1[2] *= bflo(g.w); v1[3] *= bfhi(g.w);
                    if (T) { const u32x4 t = *(const u32x4*)(T + off + bj * HALF);
                        v0[0] += bflo(t.x); v0[1] += bfhi(t.x); v0[2] += bflo(t.y); v0[3] += bfhi(t.y);
                        v1[0] += bflo(t.z); v1[1] += bfhi(t.z); v1[2] += bflo(t.w); v1[3] += bfhi(t.w); }
                    u32x4 w; w.x = cvt_pk_bf16(v0[0], v0[1]); w.y = cvt_pk_bf16(v0[2], v0[3]); w.z = cvt_pk_bf16(v1[0], v1[1]); w.w = cvt_pk_bf16(v1[2], v1[3]);
                    *(u32x4*)(O + off + bj * HALF) = w; } }
    }
};
struct EpiF32 {
    static constexpr bool PERM = false, AFTER_DRAIN = false;
    float* C; int ldc;
    __device__ __forceinline__ void operator()(const f32x4 (&acc)[2][2][4][2], const Unit& u, int wr, int wc, int fr, int fq) const {
        const int row0 = u.pm * BM + wr * 64 + fr, col0 = u.pn * BM + wc * 32 + 4 * fq;
#pragma unroll
        for (int ai = 0; ai < 2; ++ai)
#pragma unroll
            for (int m = 0; m < 4; ++m) { float* rowp = C + (size_t)(row0 + ai * HALF + m * 16) * ldc + col0;
#pragma unroll
                for (int bj = 0; bj < 2; ++bj)
#pragma unroll
                    for (int n = 0; n < 2; ++n) *(f32x4*)(rowp + bj * HALF + n * 16) = acc[ai][bj][m][n]; }
    }
};

template <class Epi, class Sched, bool ALIGN_EPI = false, bool SP2 = false>
__device__ __forceinline__ void gemm_phase(PG8_LAS unsigned char* lds, const Gemm g, const Sched& S, const Epi& E) {
    const int tid = threadIdx.x, wid = __builtin_amdgcn_readfirstlane(tid >> 6), lane = tid & 63, wr = wid >> 2, wc = wid & 3, fr = lane & 15, fq = lane >> 4;
    const int K = g.K, nt = K / BK;
    unsigned voffA[2], voffB[2];
#pragma unroll
    for (int i = 0; i < 2; ++i) { int R, C; stage_rc(tid * 16 + i * 8192, R, C); const int Rb = Epi::PERM ? ((R & ~31) + perm32(R & 31)) : R;
        voffA[i] = (unsigned)(R * K + C) * 2u; voffB[i] = (unsigned)(Rb * K + C) * 2u; }
    const size_t kstep = (size_t)(BK * 2);
    const size_t hstep = (size_t)HALF * K * 2;
    const size_t tstep = 2 * hstep;
    const unsigned ldsw = (unsigned)wid * 1024u;
    const int aoff = lds_byte(wr * 64 + fr, fq * 8), boff = lds_byte(wc * 32 + fr, fq * 8);
#define PG8_SA(b, h) (((b) * 2 + (h)) * HTB)
#define PG8_SB(b, h) ((4 + (b) * 2 + (h)) * HTB)
#define PG8_STAGE(bufoff, gbase, voff) do { _Pragma("unroll") for (int _i = 0; _i < 2; ++_i) \
        __builtin_amdgcn_global_load_lds((const unsigned*)((const char*)(gbase) + (voff)[_i]), (PG8_LAS unsigned*)(lds + (bufoff) + ldsw + _i * 8192), 16, 0, 0); } while (0)
#define PG8_LDA(dst, b, h) do { _Pragma("unroll") for (int m = 0; m < 4; ++m) _Pragma("unroll") for (int k = 0; k < 2; ++k) dst[m][k] = *(const PG8_LAS bf16x8*)(lds + PG8_SA(b, h) + aoff + m * 2048 + k * 1024); } while (0)
#define PG8_LDB(dst, b, h) do { _Pragma("unroll") for (int n = 0; n < 2; ++n) _Pragma("unroll") for (int k = 0; k < 2; ++k) dst[n][k] = *(const PG8_LAS bf16x8*)(lds + PG8_SB(b, h) + boff + n * 2048 + k * 1024); } while (0)
#define PG8_MMA(ai, bj, At, Bt) do { __builtin_amdgcn_s_setprio(1); _Pragma("unroll") for (int m = 0; m < 4; ++m) _Pragma("unroll") for (int n = 0; n < 2; ++n) _Pragma("unroll") for (int k = 0; k < 2; ++k) \
        acc[ai][bj][m][n] = __builtin_amdgcn_mfma_f32_16x16x32_bf16(Bt[n][k], At[m][k], acc[ai][bj][m][n], 0, 0, 0); __builtin_amdgcn_s_setprio(0); } while (0)
#define PG8_WAIT_V(n) asm volatile("s_waitcnt vmcnt(" #n ")" ::: "memory")
#define PG8_WAIT_L(n) asm volatile("s_waitcnt lgkmcnt(" #n ")" ::: "memory")
#define PG8_BAR __builtin_amdgcn_s_barrier()
#define PG8_SCHED __builtin_amdgcn_sched_barrier(0)
    Unit cur, nxt; int ui = 0;
    if (!S.next(0, cur)) return;
    f32x4 acc[2][2][4][2];
#pragma unroll
    for (int a = 0; a < 2; ++a)
#pragma unroll
        for (int b = 0; b < 2; ++b)
#pragma unroll
            for (int m = 0; m < 4; ++m)
#pragma unroll
                for (int n = 0; n < 2; ++n) acc[a][b][m][n] = (f32x4){0.f, 0.f, 0.f, 0.f};
    bf16x8 At[4][2], B0[2][2], B1[2][2];
    const char* cA = (const char*)g.A + (size_t)cur.pm * tstep; const char* cB = (const char*)g.Bt + (size_t)cur.pn * tstep;
    S.a_ready(cur);
    if constexpr (SP2) {
        PG8_STAGE(PG8_SB(0, 0), cB, voffB); PG8_STAGE(PG8_SB(0, 1), cB + hstep, voffB); PG8_STAGE(PG8_SA(0, 0), cA, voffA); PG8_STAGE(PG8_SA(0, 1), cA + hstep, voffA);
        if (wr == 1) PG8_BAR;
        PG8_WAIT_V(2); PG8_BAR;
        PG8_STAGE(PG8_SB(1, 0), cB + kstep, voffB); PG8_STAGE(PG8_SA(1, 0), cA + kstep, voffA); PG8_STAGE(PG8_SB(1, 1), cB + hstep + kstep, voffB);
        PG8_WAIT_V(6); PG8_BAR;
    } else {
        PG8_STAGE(PG8_SB(0, 0), cB, voffB); PG8_STAGE(PG8_SA(0, 0), cA, voffA); PG8_STAGE(PG8_SB(0, 1), cB + hstep, voffB); PG8_STAGE(PG8_SA(0, 1), cA + hstep, voffA);
        if (wr == 1) PG8_BAR;
        PG8_WAIT_V(4); PG8_BAR;
        PG8_STAGE(PG8_SB(1, 0), cB + kstep, voffB); PG8_STAGE(PG8_SA(1, 0), cA + kstep, voffA); PG8_STAGE(PG8_SB(1, 1), cB + hstep + kstep, voffB);
        PG8_WAIT_V(6); PG8_BAR;
    }
    for (;;) {
        const bool has_next = S.next(ui + 1, nxt);
        const char* nA = has_next ? (const char*)g.A + (size_t)nxt.pm * tstep : cA; const char* nB = has_next ? (const char*)g.Bt + (size_t)nxt.pn * tstep : cB;
        for (int t = 0; t < nt; t += 2) {
            const bool last = (t == nt - 2);
            const char* a1 = cA + (size_t)(t + 1) * kstep;
            const char* a2 = last ? nA : cA + (size_t)(t + 2) * kstep; const char* b2 = last ? nB : cB + (size_t)(t + 2) * kstep;
            const char* a3 = a2 + kstep; const char* b3 = b2 + kstep;
            if (last && has_next) S.a_ready(nxt);
            if constexpr (SP2) {
            PG8_LDB(B0, 0, 0); PG8_LDB(B1, 0, 1); PG8_SCHED; PG8_LDA(At, 0, 0); PG8_STAGE(PG8_SA(1, 1), a1 + hstep, voffA);
            PG8_WAIT_V(8); PG8_WAIT_L(0); PG8_BAR; PG8_MMA(0, 0, At, B0); PG8_MMA(0, 1, At, B1); PG8_BAR; PG8_SCHED;
            PG8_LDA(At, 0, 1); PG8_STAGE(PG8_SB(0, 0), b2, voffB); PG8_STAGE(PG8_SB(0, 1), b2 + hstep, voffB); PG8_STAGE(PG8_SA(0, 0), a2, voffA);
            PG8_WAIT_V(8); PG8_WAIT_L(0); PG8_BAR; PG8_MMA(1, 0, At, B0); PG8_MMA(1, 1, At, B1); PG8_BAR; PG8_SCHED;
            PG8_LDB(B0, 1, 0); PG8_LDB(B1, 1, 1); PG8_SCHED; PG8_LDA(At, 1, 0); PG8_STAGE(PG8_SA(0, 1), a2 + hstep, voffA);
            PG8_WAIT_V(8); PG8_WAIT_L(0); PG8_BAR; PG8_MMA(0, 0, At, B0); PG8_MMA(0, 1, At, B1); PG8_BAR; PG8_SCHED;
            PG8_LDA(At, 1, 1); PG8_STAGE(PG8_SB(1, 0), b3, voffB); PG8_STAGE(PG8_SB(1, 1), b3 + hstep, voffB); PG8_STAGE(PG8_SA(1, 0), a3, voffA);
            PG8_WAIT_V(8); PG8_WAIT_L(0); PG8_BAR; PG8_MMA(1, 0, At, B0); PG8_MMA(1, 1, At, B1); PG8_BAR; PG8_SCHED;
            } else {
            PG8_LDB(B0, 0, 0); PG8_SCHED; PG8_LDA(At, 0, 0); PG8_STAGE(PG8_SA(1, 1), a1 + hstep, voffA);
            PG8_WAIT_L(8); PG8_BAR; PG8_WAIT_L(0); PG8_MMA(0, 0, At, B0); PG8_BAR; PG8_SCHED;
            PG8_LDB(B1, 0, 1); PG8_STAGE(PG8_SB(0, 0), b2, voffB);
            PG8_BAR; PG8_WAIT_L(0); PG8_MMA(0, 1, At, B1); PG8_BAR;
            PG8_LDA(At, 0, 1); PG8_STAGE(PG8_SA(0, 0), a2, voffA);
            PG8_BAR; PG8_WAIT_L(0); PG8_MMA(1, 0, At, B0); PG8_BAR; PG8_SCHED;
            PG8_STAGE(PG8_SB(0, 1), b2 + hstep, voffB);
            PG8_WAIT_V(6); PG8_BAR; PG8_MMA(1, 1, At, B1); PG8_BAR;
            PG8_LDB(B0, 1, 0); PG8_SCHED; PG8_LDA(At, 1, 0); PG8_STAGE(PG8_SA(0, 1), a2 + hstep, voffA);
            PG8_WAIT_L(8); PG8_BAR; PG8_WAIT_L(0); PG8_MMA(0, 0, At, B0); PG8_BAR; PG8_SCHED;
            PG8_LDB(B1, 1, 1); PG8_STAGE(PG8_SB(1, 0), b3, voffB);
            PG8_BAR; PG8_WAIT_L(0); PG8_MMA(0, 1, At, B1); PG8_BAR;
            PG8_LDA(At, 1, 1); PG8_STAGE(PG8_SA(1, 0), a3, voffA);
            PG8_BAR; PG8_WAIT_L(0); PG8_MMA(1, 0, At, B0); PG8_BAR; PG8_SCHED;
            PG8_STAGE(PG8_SB(1, 1), b3 + hstep, voffB);
            PG8_WAIT_V(6); PG8_BAR; PG8_MMA(1, 1, At, B1); PG8_BAR;
            }
        }
        if constexpr (ALIGN_EPI) { if (wr == 0) PG8_BAR; }
        if constexpr (!Epi::AFTER_DRAIN) { E(acc, cur, wr, wc, fr, fq); S.done(cur); }
        if (!has_next) break;
#pragma unroll
        for (int a = 0; a < 2; ++a)
#pragma unroll
            for (int b = 0; b < 2; ++b)
#pragma unroll
                for (int m = 0; m < 4; ++m)
#pragma unroll
                    for (int n = 0; n < 2; ++n) acc[a][b][m][n] = (f32x4){0.f, 0.f, 0.f, 0.f};
        cur = nxt; cA = nA; cB = nB; ++ui;
        if constexpr (ALIGN_EPI) { if (wr == 1) PG8_BAR; }
    }
    PG8_WAIT_V(0);
    if constexpr (!ALIGN_EPI) { if (wr == 0) PG8_BAR; }
    PG8_BAR;
    if constexpr (Epi::AFTER_DRAIN) { E.fused(acc, cur, wr, wc, fr, fq, lds, wid, lane); S.done(cur); }
#undef PG8_SA
#undef PG8_SB
#undef PG8_STAGE
#undef PG8_LDA
#undef PG8_LDB
#undef PG8_MMA
#undef PG8_WAIT_V
#undef PG8_WAIT_L
#undef PG8_BAR
#undef PG8_SCHED
}
}

constexpr int NWAVES = 8;
constexpr int BATCH = 16, SEQ = 4096, DM = 1024, NMETA = 16;
constexpr int MR = BATCH * SEQ;
constexpr int MT = MR + 256;
constexpr int IN_W = 8712, NIN = 8704;
constexpr int GATE_COL = 4608;
constexpr float RMS_EPS = 1e-6f, LN_EPS = 1e-6f;
constexpr int PER_PHASE = 8;
constexpr int N_LAUNCHES = MK_ONE_LAUNCH ? 1 : PER_PHASE;

constexpr size_t MiB = 1u << 20;
constexpr size_t WS_CTL = 0, CTL_ZERO_BYTES = 1 * MiB;
constexpr size_t WS_W1T = 2 * MiB, WS_WAO = 19 * MiB, WS_WMO = 21 * MiB, WS_WOUT = 23 * MiB;
constexpr size_t WS_ROPE = 25 * MiB;
constexpr size_t WS_IF = 26 * MiB;
constexpr size_t WS_U = 32 * MiB;
constexpr size_t WS_KV = 161 * MiB;
constexpr size_t WS_MQK = 226 * MiB;
constexpr size_t WS_MV = 355 * MiB;
constexpr size_t WS_Q = 484 * MiB;
constexpr size_t WS_AZ = 612 * MiB;
constexpr size_t WS_MO = 740 * MiB;
constexpr size_t WS_MZ = 868 * MiB;
constexpr size_t WS_OUTF = WS_MO;
constexpr size_t WS_END = 996 * MiB;
constexpr int CW_TMO = 0, CW_CODE = 1;
constexpr int CW_BAR = 4096;

constexpr int RING_OFF = 0, RING_BYTES = 135168;
constexpr int LDSCTL_OFF = RING_BYTES, MISC_OFF = LDSCTL_OFF + 320;
constexpr int LDS_BYTES = 147456;
static_assert(MISC_OFF + 128 <= LDS_BYTES, "LDS map");

#define GAS __attribute__((address_space(1)))
#define LAS __attribute__((address_space(3)))
typedef unsigned short bf16;
typedef unsigned v4u __attribute__((ext_vector_type(4)));
typedef float f32x4 __attribute__((ext_vector_type(4)));
typedef short bf16x8 __attribute__((ext_vector_type(8)));
typedef GAS unsigned gu32;
typedef GAS unsigned long long gu64;
#define RLX_AGENT __ATOMIC_RELAXED, __HIP_MEMORY_SCOPE_AGENT
#define LDS_WAIT() asm volatile("s_waitcnt lgkmcnt(0)" ::: "memory")
#define VM_WAIT() asm volatile("s_waitcnt vmcnt(0)" ::: "memory")
__device__ __forceinline__ unsigned long long rt() { return __builtin_amdgcn_s_memrealtime(); }
__device__ __forceinline__ unsigned f2bf(float f) { unsigned u = __builtin_bit_cast(unsigned, f); return (u + 0x7fffu + ((u >> 16) & 1u)) >> 16; }
__device__ __forceinline__ unsigned pk2(float lo, float hi) { return f2bf(lo) | (f2bf(hi) << 16); }

#define XB_TMO      128
#define XB_XCNT(j)  (256  + 64 * (j))
#define XB_XSUB(j)  (1280 + 64 * (j))
#define XB_XGEN(j)  (2304 + 64 * (j))
#define XB_TOP      3328
#define XB_TOPGEN   3392
#define XCD_BAR_WORDS 3456
#define XB_SPIN_CAP (1u << 18)

__device__ __forceinline__ unsigned xb_ld(unsigned* p)              { return __hip_atomic_load(p, __ATOMIC_RELAXED, __HIP_MEMORY_SCOPE_AGENT); }
__device__ __forceinline__ unsigned xb_add(unsigned* p, unsigned v) { return __hip_atomic_fetch_add(p, v, __ATOMIC_RELAXED, __HIP_MEMORY_SCOPE_AGENT); }
__device__ __forceinline__ unsigned xb_xcc_id() { return (unsigned)__builtin_amdgcn_s_getreg((3 << 11) | 20) & 0xFu; }
#define XB_SPIN(cond, bar) do { unsigned _sp = 0; while (cond) { __builtin_amdgcn_s_sleep(1); \
    if ((++_sp & 255u) == 0u) { if (xb_ld(&(bar)[XB_TMO])) break; if (_sp > XB_SPIN_CAP) { atomicAdd(&(bar)[XB_TMO], 1u); break; } } } } while (0)

struct XcdBarrier {
    unsigned* bar; unsigned x;
    volatile LAS unsigned* st;
};

__device__ __forceinline__ XcdBarrier xcd_barrier_post(unsigned* bar, volatile LAS unsigned* st) {
    XcdBarrier b; b.bar = bar; b.x = xb_xcc_id(); b.st = st;
    if (threadIdx.x == 0) (void)xb_add(&bar[XB_XCNT(b.x)], 1u);
    return b;
}
__device__ __forceinline__ void xcd_barrier_complete(unsigned* bar, unsigned x, unsigned& nloc, unsigned& nx) {
    const unsigned G = gridDim.x * gridDim.y * gridDim.z;
    unsigned sum, cnt, mine, sp = 0u;
    for (;;) {
        sum = 0u; cnt = 0u; mine = 0u;
#pragma unroll
        for (unsigned j = 0; j < 16; ++j) { const unsigned c = xb_ld(&bar[XB_XCNT(j)]); sum += c; cnt += (c > 0u) ? 1u : 0u; mine = (j == x) ? c : mine; }
        if (sum == G) break;
        __builtin_amdgcn_s_sleep(1);
        if ((++sp & 255u) == 0u) { if (xb_ld(&bar[XB_TMO])) break; if (sp > XB_SPIN_CAP) { atomicAdd(&bar[XB_TMO], 1u); break; } }
    }
    nloc = mine > 0u ? mine : 1u; nx = cnt > 0u ? cnt : 1u;
}

__device__ __forceinline__ void xcd_barrier(const XcdBarrier& b) {
    asm volatile("s_waitcnt vmcnt(0)" ::: "memory");
    __syncthreads();
    if (threadIdx.x == 0) {
        unsigned* bar = b.bar;
        __builtin_amdgcn_s_waitcnt(0);
        unsigned nloc = b.st[0], nx = b.st[1];
        if (nloc == 0u) { xcd_barrier_complete(bar, b.x, nloc, nx); b.st[0] = nloc; b.st[1] = nx; }
        const unsigned old = xb_add(&bar[XB_XSUB(b.x)], 1u);
        const unsigned gen = old / nloc;
        if (old + 1u == (gen + 1u) * nloc) {
            __builtin_amdgcn_fence(__ATOMIC_RELEASE, "agent");
            asm volatile("s_waitcnt vmcnt(0)" ::: "memory");
            const unsigned og = xb_add(&bar[XB_TOP], 1u);
            const unsigned tg = og / nx;
            if (og + 1u == (tg + 1u) * nx) xb_add(&bar[XB_TOPGEN], 1u);
            else XB_SPIN(xb_ld(&bar[XB_TOPGEN]) == tg, bar);
            __builtin_amdgcn_fence(__ATOMIC_ACQUIRE, "agent");
            xb_add(&bar[XB_XGEN(b.x)], 1u);
            asm volatile("s_waitcnt vmcnt(0)" ::: "memory");
        } else {
            XB_SPIN(xb_ld(&bar[XB_XGEN(b.x)]) == gen, bar);
            __builtin_amdgcn_fence(__ATOMIC_ACQUIRE, "agent");
            asm volatile("s_waitcnt vmcnt(0)" ::: "memory");
        }
    }
    __syncthreads();
}

struct Frame {
    LAS unsigned char* lds;
    volatile LAS unsigned* MISC;
    gu32* ctl;
    int tid, lane, wave;
    int vcu, G;
    const float *x, *meta, *norm_pre, *w_in, *sinks, *conv_w, *conv_b, *gate_bias, *head_norm, *w_ao, *w_mo, *w_out, *norm_post;
    float* out;
    bf16 *W1T, *WAO, *WMO, *WOUT;
    float *ROPE, *IF, *OUTF;
    bf16 *U, *KV, *MQK, *MV, *Q, *AZ, *MO, *MZ, *GA, *GM;
};
__device__ __forceinline__ float wave_sum(float v) {
#pragma unroll
    for (int o = 1; o < 64; o <<= 1) v += __shfl_xor(v, o);
    return v;
}
__device__ __forceinline__ float wave_max(float v) {
#pragma unroll
    for (int o = 1; o < 64; o <<= 1) v = fmaxf(v, __shfl_xor(v, o));
    return v;
}
__device__ __forceinline__ float bf2f(bf16 v) { return __uint_as_float((unsigned)v << 16); }
__device__ __forceinline__ float bflo(unsigned w) { return __uint_as_float(w << 16); }
__device__ __forceinline__ float bfhi(unsigned w) { return __uint_as_float(w & 0xffff0000u); }

__device__ __forceinline__ void p0_transpose_item(const float* W, int ldw, int K, bf16* WT, LAS float* scr, int nblk, int item, int lane, bool skipgate) {
    const int kb = item / nblk, nb = item % nblk, k0 = 64 * kb, n0 = 32 * nb;
    const int shift = (skipgate && n0 >= GATE_COL) ? 8 : 0;
#pragma unroll 8
    for (int i = 0; i < 32; ++i) { const int kk = 2 * i + (lane >> 5); scr[kk * 33 + (lane & 31)] = W[(size_t)(k0 + kk) * ldw + n0 + shift + (lane & 31)]; }
    LDS_WAIT(); asm volatile("" ::: "memory");
    const int c = lane & 7;
#pragma unroll
    for (int j = 0; j < 4; ++j) { const int n = (lane >> 3) + 8 * j; const LAS float* s = scr + (8 * c) * 33 + n;
        v4u o; o.x = pk2(s[0 * 33], s[1 * 33]); o.y = pk2(s[2 * 33], s[3 * 33]); o.z = pk2(s[4 * 33], s[5 * 33]); o.w = pk2(s[6 * 33], s[7 * 33]);
        *(GAS v4u*)(WT + (size_t)(n0 + n) * K + k0 + 8 * c) = o; }
    LDS_WAIT(); asm volatile("" ::: "memory");
}
__device__ __forceinline__ void p0_prologue(Frame& F) {
    LAS float* scr = (LAS float*)(F.lds + RING_OFF + F.wave * 16384);
    const int gw = F.vcu * NWAVES + F.wave, NGW = F.G * NWAVES, lane = F.lane;
    constexpr int I_IN = (DM / 64) * (NIN / 32), I_SQ = (DM / 64) * (DM / 32);
    constexpr int NITEMS = I_IN + 3 * I_SQ;
    for (int it = gw; it < NITEMS; it += NGW) {
        int r = it;
        if (r < I_IN) { p0_transpose_item(F.w_in, IN_W, DM, F.W1T, scr, NIN / 32, r, lane, true); continue; } r -= I_IN;
        if (r < I_SQ) { p0_transpose_item(F.w_ao, DM, DM, F.WAO, scr, DM / 32, r, lane, false); continue; } r -= I_SQ;
        if (r < I_SQ) { p0_transpose_item(F.w_mo, DM, DM, F.WMO, scr, DM / 32, r, lane, false); continue; } r -= I_SQ;
        p0_transpose_item(F.w_out, DM, DM, F.WOUT, scr, DM / 32, r, lane, false);
    }
    {
        const int gt = F.vcu * (NWAVES * 64) + F.tid, NGT = F.G * NWAVES * 64;
        for (int idx = gt; idx < (SEQ + NMETA) * 8; idx += NGT) {
            const int pos = idx >> 3, i = idx & 7;
            const float invf = (i == 0) ? 1.0f : (i == 1) ? 0.1939227432012558f : (i == 2) ? 0.03760603070259094f : (i == 3) ? 0.007292664609849453f :
                               (i == 4) ? 0.0014142135623842478f : (i == 5) ? 0.00027424818836152554f : (i == 6) ? 5.318296098266728e-05f : 1.0313386155758053e-05f;
            const float ang = (float)pos * invf;
            double rev = (double)ang * 0.15915494309189535; rev -= floor(rev);
            const float rf = (float)rev;
            F.ROPE[(size_t)pos * 16 + i] = __builtin_amdgcn_cosf(rf);
            F.ROPE[(size_t)pos * 16 + 8 + i] = __builtin_amdgcn_sinf(rf);
        }
    }
    {
        f32x4 wg[4][4][2];
#pragma unroll
        for (int j = 0; j < 4; ++j)
#pragma unroll
            for (int i = 0; i < 4; ++i) { const float* p = F.w_in + (size_t)(256 * j + 4 * lane + i) * IN_W + GATE_COL; wg[j][i][0] = *(const f32x4*)p; wg[j][i][1] = *(const f32x4*)(p + 4); }
        f32x4 gp[4];
#pragma unroll
        for (int j = 0; j < 4; ++j) gp[j] = *(const f32x4*)(F.norm_pre + 256 * j + 4 * lane);
        for (int m = gw; m < MT; m += NGW) {
            GAS unsigned long long* o8 = (GAS unsigned long long*)(F.U + (size_t)m * DM) + lane;
            if (m >= MR + NMETA) {
#pragma unroll
                for (int j = 0; j < 4; ++j) o8[64 * j] = 0ull;
                continue;
            }
            const float* xrow = (m < MR) ? F.x + (size_t)m * DM : F.meta + (size_t)(m - MR) * DM;
            const GAS f32x4* xr = (const GAS f32x4*)xrow + lane;
            f32x4 v[4]; float s = 0.f;
#pragma unroll
            for (int j = 0; j < 4; ++j) { v[j] = xr[64 * j]; s += (v[j].x * v[j].x + v[j].y * v[j].y) + (v[j].z * v[j].z + v[j].w * v[j].w); }
            const float rstd = 1.0f / sqrtf(wave_sum(s) * (1.f / DM) + RMS_EPS);
            f32x4 ga = {0.f, 0.f, 0.f, 0.f}, gb = {0.f, 0.f, 0.f, 0.f};
#pragma unroll
            for (int j = 0; j < 4; ++j) {
                v[j] = v[j] * rstd * gp[j];
                o8[64 * j] = (unsigned long long)pk2(v[j].x, v[j].y) | ((unsigned long long)pk2(v[j].z, v[j].w) << 32);
#pragma unroll
                for (int i = 0; i < 4; ++i) { ga += wg[j][i][0] * v[j][i]; gb += wg[j][i][1] * v[j][i]; }
            }
            float g8[8];
#pragma unroll
            for (int c = 0; c < 4; ++c) { g8[c] = wave_sum(ga[c]); g8[4 + c] = wave_sum(gb[c]); }
            if (lane < 8) {
                float val = 0.f;
#pragma unroll
                for (int c = 0; c < 8; ++c) val = (lane == c) ? g8[c] : val;
                val += F.gate_bias[lane];
                if (lane >= 4) { val = fminf(val, 0.f) - log1pf(__expf(-fabsf(val))); }
                F.IF[(size_t)m * 8 + lane] = val;
            }
        }
    }
}

__device__ __forceinline__ void attn_unit_simple(Frame& F, int unit) {
    const int b = unit >> 7, rem = unit & 127, qblk = rem >> 2, kvh = rem & 3;
    LAS bf16* Ks = (LAS bf16*)(F.lds + RING_OFF);
    LAS bf16* Vs = Ks + 272 * 64;
    const int tid = F.tid;
    __syncthreads();
    for (int c = tid; c < 272 * 8 * 2; c += NWAVES * 64) {
        const int isv = c / (272 * 8), cc = c % (272 * 8), j = cc >> 3, ch = cc & 7;
        v4u val = {0u, 0u, 0u, 0u};
        long row = -1;
        if (j < 16) row = MR + j;
        else { const int sidx = qblk * 128 - 128 + (j - 16); if (sidx >= 0) row = (long)b * SEQ + sidx; }
        if (row >= 0) val = *(const GAS v4u*)(F.KV + (size_t)row * 512 + isv * 256 + kvh * 64 + ch * 8);
        *(LAS v4u*)((isv ? Vs : Ks) + j * 64 + ch * 8) = val;
    }
    __syncthreads();
    const int g = tid >> 7, qi = tid & 127, head = kvh * 4 + g;
    const size_t qrow = (size_t)b * SEQ + qblk * 128 + qi;
    float q[64], o[64];
    {
        const GAS v4u* qp = (const GAS v4u*)(F.Q + qrow * DM + head * 64);
#pragma unroll
        for (int c = 0; c < 8; ++c) { const v4u w = qp[c];
            q[8 * c + 0] = bflo(w.x); q[8 * c + 1] = bfhi(w.x); q[8 * c + 2] = bflo(w.y); q[8 * c + 3] = bfhi(w.y);
            q[8 * c + 4] = bflo(w.z); q[8 * c + 5] = bfhi(w.z); q[8 * c + 6] = bflo(w.w); q[8 * c + 7] = bfhi(w.w); }
    }
#pragma unroll
    for (int d = 0; d < 64; ++d) o[d] = 0.f;
    float mx = F.sinks[head], l = 1.0f;
    for (int j = 0; j < 272; ++j) {
        bool valid;
        if (j < 16) valid = true;
        else { const int kj = j - 16; valid = (kj > qi) && (kj <= qi + 128) && (qblk * 128 + kj - 128 >= 0); }
        if (valid) {
            float s = 0.f;
#pragma unroll
            for (int c = 0; c < 8; ++c) { const v4u w = *(const LAS v4u*)(Ks + j * 64 + c * 8);
                s += q[8 * c + 0] * bflo(w.x) + q[8 * c + 1] * bfhi(w.x) + q[8 * c + 2] * bflo(w.y) + q[8 * c + 3] * bfhi(w.y)
                   + q[8 * c + 4] * bflo(w.z) + q[8 * c + 5] * bfhi(w.z) + q[8 * c + 6] * bflo(w.w) + q[8 * c + 7] * bfhi(w.w); }
            const float mn = fmaxf(mx, s), al = __expf(mx - mn), p = __expf(s - mn);
            l = l * al + p; mx = mn;
#pragma unroll
            for (int c = 0; c < 8; ++c) { const v4u w = *(const LAS v4u*)(Vs + j * 64 + c * 8);
                o[8 * c + 0] = o[8 * c + 0] * al + p * bflo(w.x); o[8 * c + 1] = o[8 * c + 1] * al + p * bfhi(w.x);
                o[8 * c + 2] = o[8 * c + 2] * al + p * bflo(w.y); o[8 * c + 3] = o[8 * c + 3] * al + p * bfhi(w.y);
                o[8 * c + 4] = o[8 * c + 4] * al + p * bflo(w.z); o[8 * c + 5] = o[8 * c + 5] * al + p * bfhi(w.z);
                o[8 * c + 6] = o[8 * c + 6] * al + p * bflo(w.w); o[8 * c + 7] = o[8 * c + 7] * al + p * bfhi(w.w); }
        }
    }
    const float rl = 1.0f / l;
    const GAS v4u* zp = (const GAS v4u*)(F.AZ + qrow * DM + head * 64);
    GAS v4u* op = (GAS v4u*)(F.Q + qrow * DM + head * 64);
#pragma unroll
    for (int c = 0; c < 8; ++c) { const v4u z = zp[c]; v4u w;
        w.x = pk2(o[8 * c + 0] * rl * bflo(z.x), o[8 * c + 1] * rl * bfhi(z.x)); w.y = pk2(o[8 * c + 2] * rl * bflo(z.y), o[8 * c + 3] * rl * bfhi(z.y));
        w.z = pk2(o[8 * c + 4] * rl * bflo(z.z), o[8 * c + 5] * rl * bfhi(z.z)); w.w = pk2(o[8 * c + 6] * rl * bflo(z.w), o[8 * c + 7] * rl * bfhi(z.w));
        op[c] = w; }
}

__device__ __forceinline__ long seqrow(int b, int p) { return p < NMETA ? (long)MR + p : (long)b * SEQ + (p - NMETA); }
__device__ __forceinline__ void mlstm_chain_simple(Frame& F, int chain) {
    const int b = chain >> 4, h = (chain >> 2) & 3, vsl = chain & 3;
    LAS float* qs = (LAS float*)(F.lds + RING_OFF);
    LAS float* ks = qs + 64 * 129;
    LAS float* Cs = ks + 64 * 129;
    LAS float* vv = Cs + 64 * 129;
    LAS float* Ss = vv + 64 * 65;
    LAS float* ns = Ss + 64 * 65;
    LAS float* bc = ns + 128;
    LAS float* lis = bc + 64; LAS float* lfs = lis + 64; LAS float* mr = lfs + 64; LAS float* wi = mr + 64; LAS float* wa = wi + 64; LAS float* dn = wa + 64;
    LAS float* misc = dn + 64;
    const int tid = F.tid;
    constexpr int NT = NWAVES * 64;
    __syncthreads();
    for (int i = tid; i < 64 * 129; i += NT) Cs[i] = 0.f;
    if (tid < 128) ns[tid] = 0.f;
    if (tid == 0) misc[0] = 0.f;
    __syncthreads();
    for (int c = 0; c < 65; ++c) {
        for (int idx = tid; idx < 64 * 128; idx += NT) {
            const int t = idx >> 7, d = idx & 127, p = c * 64 + t - 48;
            float qv = 0.f, kv = 0.f;
            if (p >= 0) {
                const int cq = h * 128 + d, ck = 512 + h * 128 + d;
                float aq = F.conv_b[cq], ak = F.conv_b[ck];
#pragma unroll
                for (int j = 0; j < 4; ++j) { const int pp = p - 3 + j;
                    if (pp >= 0) { const bf16* rp = F.MQK + (size_t)seqrow(b, pp) * DM; aq += F.conv_w[j * 1024 + cq] * bf2f(rp[cq]); ak += F.conv_w[j * 1024 + ck] * bf2f(rp[ck]); } }
                qv = aq / (1.0f + __expf(-aq)); kv = ak / (1.0f + __expf(-ak)) * 0.08838834764831845f;
            }
            qs[t * 129 + d] = qv; ks[t * 129 + d] = kv;
        }
        for (int idx = tid; idx < 64 * 64; idx += NT) {
            const int t = idx >> 6, vi = idx & 63, p = c * 64 + t - 48;
            vv[t * 65 + vi] = (p >= 0) ? bf2f(F.MV[(size_t)seqrow(b, p) * DM + h * 256 + vsl * 64 + vi]) : 0.f;
        }
        if (tid < 64) { const int p = c * 64 + tid - 48;
            lis[tid] = (p >= 0) ? F.IF[(size_t)seqrow(b, p) * 8 + h] : -1e30f;
            lfs[tid] = (p >= 0) ? F.IF[(size_t)seqrow(b, p) * 8 + 4 + h] : 0.f; }
        __syncthreads();
        if (tid < 64) { float a = 0.f; for (int s = 0; s <= tid; ++s) a += lfs[s]; bc[tid] = a; }
        __syncthreads();
        for (int idx = tid; idx < 64 * 64; idx += NT) {
            const int t = idx >> 6, s = idx & 63; float a = 0.f;
            if (s <= t) { for (int d = 0; d < 128; ++d) a += qs[t * 129 + d] * ks[s * 129 + d]; }
            Ss[t * 65 + s] = a;
        }
        if (tid < 64) {
            const int t = tid; const float m = misc[0], bt = bc[t];
            float mx = bt + m;
            for (int s = 0; s <= t; ++s) mx = fmaxf(mx, bt - bc[s] + lis[s]);
            mr[t] = mx; wi[t] = __expf(bt + m - mx);
            const float bl = bc[63], a = bl - bt + lis[t];
            const float mnew = fmaxf(bl + m, wave_max(a));
            wa[t] = __expf(a - mnew);
            if (t == 0) { misc[1] = mnew; misc[2] = __expf(bl + m - mnew); }
        }
        __syncthreads();
        for (int idx = tid; idx < 64 * 64; idx += NT) {
            const int t = idx >> 6, s = idx & 63;
            Ss[t * 65 + s] = (s <= t) ? Ss[t * 65 + s] * __expf(bc[t] - bc[s] + lis[s] - mr[t]) : 0.f;
        }
        __syncthreads();
        if (tid < 64) { const int t = tid; float a = 0.f, s2 = 0.f;
            for (int d = 0; d < 128; ++d) a += qs[t * 129 + d] * ns[d];
            for (int s = 0; s < 64; ++s) s2 += Ss[t * 65 + s];
            const float den = wi[t] * a + s2;
            dn[t] = fmaxf(fabsf(den), __expf(-mr[t])); }
        __syncthreads();
        for (int idx = tid; idx < 64 * 64; idx += NT) {
            const int t = idx >> 6, vi = idx & 63; float a = 0.f, s2 = 0.f;
            for (int d = 0; d < 128; ++d) a += qs[t * 129 + d] * Cs[vi * 129 + d];
            for (int s = 0; s < 64; ++s) s2 += Ss[t * 65 + s] * vv[s * 65 + vi];
            const float hval = (wi[t] * a + s2) / dn[t];
            if (c >= 1) F.MV[((size_t)b * SEQ + (size_t)(c - 1) * 64 + t) * DM + h * 256 + vsl * 64 + vi] = (bf16)f2bf(hval);
        }
        __syncthreads();
        {
            const float wc_ = misc[2];
            for (int idx = tid; idx < 64 * 128; idx += NT) {
                const int vi = idx >> 7, d = idx & 127; float a = 0.f;
                for (int s = 0; s < 64; ++s) a += wa[s] * vv[s * 65 + vi] * ks[s * 129 + d];
                Cs[vi * 129 + d] = wc_ * Cs[vi * 129 + d] + a;
            }
            if (tid < 128) { float a = 0.f; for (int s = 0; s < 64; ++s) a += wa[s] * ks[s * 129 + tid]; ns[tid] = wc_ * ns[tid] + a; }
        }
        __syncthreads();
        if (tid == 0) misc[0] = misc[1];
        __syncthreads();
    }
}

__device__ __forceinline__ void p3_min(Frame& F) {
    const int gw = F.vcu * NWAVES + F.wave, NGW = F.G * NWAVES, lane = F.lane;
    for (int m = gw; m < MR; m += NGW) {
#pragma unroll
        for (int hh = 0; hh < 4; ++hh) {
            const size_t off = (size_t)m * DM + hh * 256 + 4 * lane;
            const unsigned long long cw = *(const GAS unsigned long long*)(F.MV + off), ow = *(const GAS unsigned long long*)(F.MO + off), zw = *(const GAS unsigned long long*)(F.MZ + off);
            const f32x4 gm = *(const f32x4*)(F.head_norm + hh * 256 + 4 * lane);
            float xv[4];
            xv[0] = bflo((unsigned)cw) * bflo((unsigned)ow); xv[1] = bfhi((unsigned)cw) * bfhi((unsigned)ow);
            xv[2] = bflo((unsigned)(cw >> 32)) * bflo((unsigned)(ow >> 32)); xv[3] = bfhi((unsigned)(cw >> 32)) * bfhi((unsigned)(ow >> 32));
            const float mu = wave_sum((xv[0] + xv[1]) + (xv[2] + xv[3])) * (1.f / 256.f);
            float q = 0.f;
#pragma unroll
            for (int e = 0; e < 4; ++e) { xv[e] -= mu; q += xv[e] * xv[e]; }
            const float rstd = 1.0f / sqrtf(wave_sum(q) * (1.f / 256.f) + LN_EPS);
            const float z0 = bflo((unsigned)zw), z1 = bfhi((unsigned)zw), z2 = bflo((unsigned)(zw >> 32)), z3 = bfhi((unsigned)(zw >> 32));
            const unsigned lo = pk2(xv[0] * rstd * gm[0] * z0, xv[1] * rstd * gm[1] * z1), hi = pk2(xv[2] * rstd * gm[2] * z2, xv[3] * rstd * gm[3] * z3);
            *(GAS unsigned long long*)(F.MV + off) = (unsigned long long)lo | ((unsigned long long)hi << 32);
        }
    }
}
__device__ __forceinline__ void p7_final(Frame& F) {
    const int gw = F.vcu * NWAVES + F.wave, NGW = F.G * NWAVES, lane = F.lane;
    f32x4 gp[4];
#pragma unroll
    for (int j = 0; j < 4; ++j) gp[j] = *(const f32x4*)(F.norm_post + 256 * j + 4 * lane);
    for (int m = gw; m < MR; m += NGW) {
        const GAS f32x4* yr = (const GAS f32x4*)(F.OUTF + (size_t)m * DM) + lane;
        const GAS f32x4* xr = (const GAS f32x4*)(F.x + (size_t)m * DM) + lane;
        GAS f32x4* orow = (GAS f32x4*)(F.out + (size_t)m * DM) + lane;
        f32x4 v[4], xv[4]; float s = 0.f;
#pragma unroll
        for (int j = 0; j < 4; ++j) { v[j] = yr[64 * j]; xv[j] = xr[64 * j]; s += (v[j].x * v[j].x + v[j].y * v[j].y) + (v[j].z * v[j].z + v[j].w * v[j].w); }
        const float rstd = 1.0f / sqrtf(wave_sum(s) * (1.f / DM) + RMS_EPS);
#pragma unroll
        for (int j = 0; j < 4; ++j) orow[64 * j] = xv[j] + v[j] * rstd * gp[j];
    }
}

struct Args { const float* in[13]; float* out; unsigned char* ws; int ph_lo, ph_hi, li, pad; };
__global__ void __launch_bounds__(NWAVES * 64, 2) hyb_fwd(Args args) {
    extern __shared__ __attribute__((aligned(16))) unsigned char lds[];
    Frame F;
    F.lds = (LAS unsigned char*)lds;
    F.MISC = (volatile LAS unsigned*)(F.lds + MISC_OFF);
    F.tid = threadIdx.x; F.lane = F.tid & 63; F.wave = __builtin_amdgcn_readfirstlane(F.tid >> 6);
    F.G = gridDim.x; { const int bx = blockIdx.x; F.vcu = (F.G % 8 == 0) ? (bx % 8) * (F.G / 8) + bx / 8 : bx; }
    unsigned char* ws = args.ws;
    F.ctl = (gu32*)(ws + WS_CTL);
    F.x = args.in[0]; F.meta = args.in[1]; F.norm_pre = args.in[2]; F.w_in = args.in[3]; F.sinks = args.in[4]; F.conv_w = args.in[5]; F.conv_b = args.in[6];
    F.gate_bias = args.in[7]; F.head_norm = args.in[8]; F.w_ao = args.in[9]; F.w_mo = args.in[10]; F.w_out = args.in[11]; F.norm_post = args.in[12];
    F.out = args.out;
    F.W1T = (bf16*)(ws + WS_W1T); F.WAO = (bf16*)(ws + WS_WAO); F.WMO = (bf16*)(ws + WS_WMO); F.WOUT = (bf16*)(ws + WS_WOUT);
    F.ROPE = (float*)(ws + WS_ROPE); F.IF = (float*)(ws + WS_IF); F.OUTF = (float*)(ws + WS_OUTF);
    F.U = (bf16*)(ws + WS_U); F.KV = (bf16*)(ws + WS_KV); F.MQK = (bf16*)(ws + WS_MQK); F.MV = (bf16*)(ws + WS_MV); F.Q = (bf16*)(ws + WS_Q);
    F.AZ = (bf16*)(ws + WS_AZ); F.MO = (bf16*)(ws + WS_MO); F.MZ = (bf16*)(ws + WS_MZ);
    F.GA = (bf16*)args.out; F.GM = (bf16*)args.out + (size_t)MR * DM;
    for (int u = F.tid; u < (LDS_BYTES - LDSCTL_OFF) / 4; u += NWAVES * 64) ((LAS unsigned*)(F.lds + LDSCTL_OFF))[u] = 0u;
    __syncthreads();
    XcdBarrier bar; bar.bar = (unsigned*)(F.ctl + CW_BAR); bar.x = 0; bar.st = nullptr;
    if (N_LAUNCHES == 1) bar = xcd_barrier_post((unsigned*)(F.ctl + CW_BAR), F.MISC + 8);
#define GRID_BAR() do { if (N_LAUNCHES == 1) xcd_barrier(bar); } while (0)
    const int lo = args.ph_lo, hi = args.ph_hi;
#define IN(k) (lo <= (k) && (k) < hi)
#define BOTH(k) (IN(k) && IN((k) + 1))

    if (IN(0)) { p0_prologue(F); if (BOTH(0)) GRID_BAR(); }

    if (IN(1)) {
        pg8::Gemm g{F.U, F.W1T, MT, NIN, DM}; pg8::StaticOrder S; S.init(MT, NIN, F.G, (int)blockIdx.x);
        pg8::EpiInProj E{args.ws, (unsigned char*)args.out, F.ROPE};
        static_assert(WS_Q == 484 * MiB && WS_KV == 161 * MiB && WS_AZ == 612 * MiB && WS_MQK == 226 * MiB && WS_MV == 355 * MiB && WS_MO == 740 * MiB && WS_MZ == 868 * MiB, "EpiInProj offsets");
        pg8::gemm_phase<pg8::EpiInProj, pg8::StaticOrder, true, true>(F.lds + RING_OFF, g, S, E);
        if (BOTH(1)) GRID_BAR();
    }

    if (IN(2)) {
        for (int u = blockIdx.x; u < BATCH * 32 * 4; u += F.G) attn_unit_simple(F, u);
        for (int c = blockIdx.x; c < BATCH * 16; c += F.G) mlstm_chain_simple(F, c);
        if (BOTH(2)) GRID_BAR();
    }

    if (IN(3)) { p3_min(F); if (BOTH(3)) GRID_BAR(); }

    if (IN(4)) {
        pg8::Gemm g{F.Q, F.WAO, MR, DM, DM}; pg8::StaticOrder S; S.init(MR, DM, F.G, (int)blockIdx.x);
        pg8::EpiGate E{F.GA, nullptr, F.AZ};
        pg8::gemm_phase<pg8::EpiGate, pg8::StaticOrder, true, true>(F.lds + RING_OFF, g, S, E);
        if (BOTH(4)) GRID_BAR();
    }
    if (IN(5)) {
        pg8::Gemm g{F.MV, F.WMO, MR, DM, DM}; pg8::StaticOrder S; S.init(MR, DM, F.G, (int)blockIdx.x);
        pg8::EpiGate E{F.GM, F.AZ, F.MQK};
        pg8::gemm_phase<pg8::EpiGate, pg8::StaticOrder, true, true>(F.lds + RING_OFF, g, S, E);
        if (BOTH(5)) GRID_BAR();
    }
    if (IN(6)) {
        pg8::Gemm g{F.MQK, F.WOUT, MR, DM, DM}; pg8::StaticOrder S; S.init(MR, DM, F.G, (int)blockIdx.x);
        pg8::EpiF32 E{F.OUTF, DM};
        pg8::gemm_phase<pg8::EpiF32, pg8::StaticOrder, true, true>(F.lds + RING_OFF, g, S, E);
        if (BOTH(6)) GRID_BAR();
    }
    if (IN(7)) { p7_final(F); }
#undef IN
#undef BOTH
}

extern "C" void kernel_launch(void* const* d_in, const int* in_sizes, int n_in, void* d_out, int out_size, void* d_ws, size_t ws_size, hipStream_t stream) {
    static int grid = 0;
    if (grid == 0) {
        if (n_in != 13 || in_sizes[0] != MR * DM || out_size != MR * DM || ws_size < WS_END) { fprintf(stderr, "kernel_launch: unexpected shapes (n_in %d, in0 %d, out %d, ws %zu); nothing launched\n", n_in, n_in > 0 ? in_sizes[0] : -1, out_size, ws_size); grid = -1; return; }
        int dev = 0, cus = 0, per_cu = 0;
        if (hipGetDevice(&dev) != hipSuccess || hipDeviceGetAttribute(&cus, hipDeviceAttributeMultiprocessorCount, dev) != hipSuccess) { grid = -1; return; }
        if (hipFuncSetAttribute((const void*)hyb_fwd, hipFuncAttributeMaxDynamicSharedMemorySize, LDS_BYTES) != hipSuccess) { fprintf(stderr, "kernel_launch: hipFuncSetAttribute failed\n"); grid = -1; return; }
        if (hipOccupancyMaxActiveBlocksPerMultiprocessor(&per_cu, (const void*)hyb_fwd, NWAVES * 64, LDS_BYTES) != hipSuccess || per_cu < 1)
            fprintf(stderr, "kernel_launch: note: occupancy query reports %d workgroups per CU\n", per_cu);
        (void)hipGetLastError();
        grid = cus;
    }
    if (grid < 0) return;
    if (hipMemsetAsync((char*)d_ws + WS_CTL, 0, CTL_ZERO_BYTES, stream) != hipSuccess) { fprintf(stderr, "kernel_launch: hipMemsetAsync failed\n"); return; }
    Args a{};
    for (int i = 0; i < 13; ++i) a.in[i] = (const float*)d_in[i];
    a.out = (float*)d_out; a.ws = (unsigned char*)d_ws;
    for (int li = 0; li < N_LAUNCHES; ++li) {
        a.ph_lo = (N_LAUNCHES == 1) ? 0 : li; a.ph_hi = (N_LAUNCHES == 1) ? PER_PHASE : li + 1; a.li = li;
        hipLaunchKernelGGL(hyb_fwd, dim3(grid), dim3(NWAVES * 64), LDS_BYTES, stream, a);
        const hipError_t le = hipPeekAtLastError();
        if (le != hipSuccess) { fprintf(stderr, "kernel_launch: launch %d failed: %s\n", li, hipGetErrorName(le)); break; }
    }
}
```

```cpp
#include <hip/hip_runtime.h>
#include <cstdio>
#include <cstdint>
#ifndef MK_ONE_LAUNCH
#define MK_ONE_LAUNCH 1
#endif
namespace pg8 {
#define PG8_LAS __attribute__((address_space(3)))
typedef unsigned short bf16_t;
typedef short bf16x8 __attribute__((ext_vector_type(8)));
typedef float f32x4 __attribute__((ext_vector_type(4)));
typedef unsigned u32x4 __attribute__((ext_vector_type(4)));
constexpr int BM = 256, BK = 64, HALF = 128, HTB = HALF * BK * 2  , STAGE_BYTES = 8 * HTB, NXCD = 8, WGM = 8;

__host__ __device__ __forceinline__ int lds_byte(int r, int c) { const int st = (r >> 4) * 2 + (c >> 5), rr = r & 15, cc = c & 31, ob = rr * 64 + cc * 2; return st * 1024 + (ob ^ (((ob >> 9) & 1) << 5)); }
__host__ __device__ __forceinline__ void stage_rc(int b, int& R, int& C) { const int st = b / 1024, sb = b % 1024, swz = sb ^ (((sb >> 9) & 1) << 5); R = (st >> 1) * 16 + swz / 64; C = (st & 1) * 32 + (swz % 64) / 2; }
__host__ __device__ __forceinline__ int perm32(int rho) { const int n = rho >> 4, i = rho & 15; return 8 * (i >> 2) + 4 * n + (i & 3); }

struct Unit { int pm, pn; };
struct Gemm { const bf16_t* A; const bf16_t* Bt; int M, N, K; };

struct StaticOrder {
    int nM, nN, nwg, G, c;
    __host__ __device__ void init(int M, int N, int G_, int c_) { nM = M / BM; nN = N / BM; nwg = nM * nN; G = G_; c = c_; }
    __host__ __device__ bool next(int i, Unit& u) const {
        const long L = (long)i * G + c; if (L >= nwg) return false;
        int wgid = (int)L; { const int q = nwg / NXCD, r = nwg % NXCD, xcd = wgid % NXCD, off = wgid / NXCD; wgid = (xcd < r ? xcd * (q + 1) : r * (q + 1) + (xcd - r) * q) + off; }
        const int nig = WGM * nN, gid = wgid / nig, fm = gid * WGM, gsz = (nM - fm) < WGM ? (nM - fm) : WGM;
        u.pm = fm + ((wgid % nig) % gsz); u.pn = (wgid % nig) / gsz; return true;
    }
    __device__ __forceinline__ void a_ready(const Unit&) const {}
    __device__ __forceinline__ void done(const Unit&) const {}
};

__device__ __forceinline__ unsigned cvt_pk_bf16(float lo, float hi) { unsigned r; asm volatile("v_cvt_pk_bf16_f32 %0, %1, %2" : "=v"(r) : "v"(lo), "v"(hi)); return r; }
__device__ __forceinline__ float bflo(unsigned w) { return __uint_as_float(w << 16); }
__device__ __forceinline__ float bfhi(unsigned w) { return __uint_as_float(w & 0xffff0000u); }
__device__ __forceinline__ float sigmoidf_(float x) { return 1.0f / (1.0f + __expf(-x)); }
__device__ __forceinline__ float siluf_(float x) { return x / (1.0f + __expf(-x)); }

constexpr int ROWS_REAL = 65536;

struct EpiInProj {
    static constexpr bool PERM = true, AFTER_DRAIN = false;
    unsigned char* ws; unsigned char* dout; const float* rope;
    __device__ __forceinline__ void operator()(const f32x4 (&acc)[2][2][4][2], const Unit& u, int wr, int wc, int fr, int fq) const {
        const int pn = u.pn; size_t boff; int ldc = 1024, colt, act; bool meta = false;
        constexpr size_t MB = 1u << 20;
        if (pn < 4)       { boff = 484 * MB; colt = pn * 256;        act = 4; }
        else if (pn == 4) { boff = 161 * MB; colt = 0;   ldc = 512;  act = 3; meta = true; }
        else if (pn == 5) { boff = 161 * MB; colt = 256; ldc = 512;  act = 0; meta = true; }
        else if (pn < 10) { boff = 612 * MB; colt = (pn - 6) * 256;  act = 1; }
        else if (pn < 14) { boff = 226 * MB; colt = (pn - 10) * 256; act = 0; meta = true; }
        else if (pn < 18) { boff = 355 * MB; colt = (pn - 14) * 256; act = 0; meta = true; }
        else if (pn < 22) { boff = 740 * MB; colt = (pn - 18) * 256; act = 2; }
        else if (pn < 26) { boff = 868 * MB; colt = (pn - 22) * 256; act = 1; }
        else if (pn < 30) { boff = 0;        colt = (pn - 26) * 256; act = 2; }
        else              { boff = 128 * MB; colt = (pn - 30) * 256; act = 2; }
        bf16_t* base = (bf16_t*)((pn >= 26 ? dout : ws) + boff);
        if (u.pm == 256 && !meta) return;
        const int row0 = u.pm * BM + wr * 64 + fr, col0 = colt + wc * 32 + 8 * fq;
        const bool ropel = ((wc & 1) == 0) && (fq < 2);
#pragma unroll
        for (int ai = 0; ai < 2; ++ai)
#pragma unroll
            for (int m = 0; m < 4; ++m) {
                const int row = row0 + ai * HALF + m * 16;
                bf16_t* rowp = base + (size_t)row * ldc + col0;
                f32x4 cs0, cs1, sn0, sn1;
                if (act >= 3) { const int pos = (u.pm == 256) ? (row - ROWS_REAL) : 16 + (row & 4095); const float* rp = rope + (size_t)pos * 16;
                    cs0 = *(const f32x4*)(rp); cs1 = *(const f32x4*)(rp + 4); sn0 = *(const f32x4*)(rp + 8); sn1 = *(const f32x4*)(rp + 12); }
#pragma unroll
                for (int bj = 0; bj < 2; ++bj) {
                    f32x4 v0 = acc[ai][bj][m][0], v1 = acc[ai][bj][m][1];
                    if (act == 1) {
#pragma unroll
                        for (int e = 0; e < 4; ++e) { v0[e] = siluf_(v0[e]); v1[e] = siluf_(v1[e]); }
                    } else if (act == 2) {
#pragma unroll
                        for (int e = 0; e < 4; ++e) { v0[e] = sigmoidf_(v0[e]); v1[e] = sigmoidf_(v1[e]); }
                    } else if (act >= 3) {
                        f32x4 p0, p1;
#pragma unroll
                        for (int e = 0; e < 4; ++e) { p0[e] = __shfl_xor(v0[e], 16); p1[e] = __shfl_xor(v1[e], 16); }
                        if (ropel) {
                            if (fq == 0) { v0 = v0 * cs0 - p0 * sn0; v1 = v1 * cs1 - p1 * sn1; }
                            else         { v0 = v0 * cs0 + p0 * sn0; v1 = v1 * cs1 + p1 * sn1; }
                        }
                        if (act == 4) { v0 = v0 * 0.125f; v1 = v1 * 0.125f; }
                    }
                    u32x4 w; w.x = cvt_pk_bf16(v0[0], v0[1]); w.y = cvt_pk_bf16(v0[2], v0[3]); w.z = cvt_pk_bf16(v1[0], v1[1]); w.w = cvt_pk_bf16(v1[2], v1[3]);
                    *(u32x4*)(rowp + bj * HALF) = w;
                }
            }
    }
};
struct EpiGate {
    static constexpr bool PERM = true, AFTER_DRAIN = false;
    const bf16_t* G; const bf16_t* T; bf16_t* O;
    __device__ __forceinline__ void operator()(const f32x4 (&acc)[2][2][4][2], const Unit& u, int wr, int wc, int fr, int fq) const {
        const int row0 = u.pm * BM + wr * 64 + fr, col0 = u.pn * BM + wc * 32 + 8 * fq;
#pragma unroll
        for (int ai = 0; ai < 2; ++ai)
#pragma unroll
            for (int m = 0; m < 4; ++m) { const size_t off = (size_t)(row0 + ai * HALF + m * 16) * 1024 + col0;
#pragma unroll
                for (int bj = 0; bj < 2; ++bj) {
                    const u32x4 g = *(const u32x4*)(G + off + bj * HALF);
                    f32x4 v0 = acc[ai][bj][m][0], v1 = acc[ai][bj][m][1];
                    v0[0] *= bflo(g.x); v0[1] *= bfhi(g.x); v0[2] *= bflo(g.y); v0[3] *= bfhi(g.y);
                    v1[0] *= bflo(g.z); v1[1] *= bfhi(g.z); v1[2] *= bflo(g.w); v1[3] *= bfhi(g.w);
                    if (T) { const u32x4 t = *(const u32x4*)(T + off + bj * HALF);
                        v0[0] += bflo(t.x); v0[1] += bfhi(t.x); v0[2] += bflo(t.y); v0[3] += bfhi(t.y);
                        v1[0] += bflo(t.z); v1[1] += bfhi(t.z); v1[2] += bflo(t.w); v1[3] += bfhi(t.w); }
                    u32x4 w; w.x = cvt_pk_bf16(v0[0], v0[1]); w.y = cvt_pk_bf16(v0[2], v0[3]); w.z = cvt_pk_bf16(v1[0], v1[1]); w.w = cvt_pk_bf16(v1[2], v1[3]);
                    *(u32x4*)(O + off + bj * HALF) = w; } }
    }
};
struct EpiF32 {
    static constexpr bool PERM = false, AFTER_DRAIN = false;
    float* C; int ldc;
    __device__ __forceinline__ void operator()(const f32x4 (&acc)[2][2][4][2], const Unit& u, int wr, int wc, int fr, int fq) const {
        const int row0 = u.pm * BM + wr * 64 + fr, col0 = u.pn * BM + wc * 32 + 4 * fq;
#pragma unroll
        for (int ai = 0; ai < 2; ++ai)
#pragma unroll
            for (int m = 0; m < 4; ++m) { float* rowp = C + (size_t)(row0 + ai * HALF + m * 16) * ldc + col0;
#pragma unroll
                for (int bj = 0; bj < 2; ++bj)
#pragma unroll
                    for (int n = 0; n < 2; ++n) *(f32x4*)(rowp + bj * HALF + n * 16) = acc[ai][bj][m][n]; }
    }
};

template <class Epi, class Sched, bool ALIGN_EPI = false, bool SP2 = false>
__device__ __forceinline__ void gemm_phase(PG8_LAS unsigned char* lds, const Gemm g, const Sched& S, const Epi& E) {
    const int tid = threadIdx.x, wid = __builtin_amdgcn_readfirstlane(tid >> 6), lane = tid & 63, wr = wid >> 2, wc = wid & 3, fr = lane & 15, fq = lane >> 4;
    const int K = g.K, nt = K / BK;
    unsigned voffA[2], voffB[2];
#pragma unroll
    for (int i = 0; i < 2; ++i) { int R, C; stage_rc(tid * 16 + i * 8192, R, C); const int Rb = Epi::PERM ? ((R & ~31) + perm32(R & 31)) : R;
        voffA[i] = (unsigned)(R * K + C) * 2u; voffB[i] = (unsigned)(Rb * K + C) * 2u; }
    const size_t kstep = (size_t)(BK * 2);
    const size_t hstep = (size_t)HALF * K * 2;
    const size_t tstep = 2 * hstep;
    const unsigned ldsw = (unsigned)wid * 1024u;
    const int aoff = lds_byte(wr * 64 + fr, fq * 8), boff = lds_byte(wc * 32 + fr, fq * 8);
#define PG8_SA(b, h) (((b) * 2 + (h)) * HTB)
#define PG8_SB(b, h) ((4 + (b) * 2 + (h)) * HTB)
#define PG8_STAGE(bufoff, gbase, voff) do { _Pragma("unroll") for (int _i = 0; _i < 2; ++_i) \
        __builtin_amdgcn_global_load_lds((const unsigned*)((const char*)(gbase) + (voff)[_i]), (PG8_LAS unsigned*)(lds + (bufoff) + ldsw + _i * 8192), 16, 0, 0); } while (0)
#define PG8_LDA(dst, b, h) do { _Pragma("unroll") for (int m = 0; m < 4; ++m) _Pragma("unroll") for (int k = 0; k < 2; ++k) dst[m][k] = *(const PG8_LAS bf16x8*)(lds + PG8_SA(b, h) + aoff + m * 2048 + k * 1024); } while (0)
#define PG8_LDB(dst, b, h) do { _Pragma("unroll") for (int n = 0; n < 2; ++n) _Pragma("unroll") for (int k = 0; k < 2; ++k) dst[n][k] = *(const PG8_LAS bf16x8*)(lds + PG8_SB(b, h) + boff + n * 2048 + k * 1024); } while (0)
#define PG8_MMA(ai, bj, At, Bt) do { __builtin_amdgcn_s_setprio(1); _Pragma("unroll") for (int m = 0; m < 4; ++m) _Pragma("unroll") for (int n = 0; n < 2; ++n) _Pragma("unroll") for (int k = 0; k < 2; ++k) \
        acc[ai][bj][m][n] = __builtin_amdgcn_mfma_f32_16x16x32_bf16(Bt[n][k], At[m][k], acc[ai][bj][m][n], 0, 0, 0); __builtin_amdgcn_s_setprio(0); } while (0)
#define PG8_WAIT_V(n) asm volatile("s_waitcnt vmcnt(" #n ")" ::: "memory")
#define PG8_WAIT_L(n) asm volatile("s_waitcnt lgkmcnt(" #n ")" ::: "memory")
#define PG8_BAR __builtin_amdgcn_s_barrier()
#define PG8_SCHED __builtin_amdgcn_sched_barrier(0)
    Unit cur, nxt; int ui = 0;
    if (!S.next(0, cur)) return;
    f32x4 acc[2][2][4][2];
#pragma unroll
    for (int a = 0; a < 2; ++a)
#pragma unroll
        for (int b = 0; b < 2; ++b)
#pragma unroll
            for (int m = 0; m < 4; ++m)
#pragma unroll
                for (int n = 0; n < 2; ++n) acc[a][b][m][n] = (f32x4){0.f, 0.f, 0.f, 0.f};
    bf16x8 At[4][2], B0[2][2], B1[2][2];
    const char* cA = (const char*)g.A + (size_t)cur.pm * tstep; const char* cB = (const char*)g.Bt + (size_t)cur.pn * tstep;
    S.a_ready(cur);
    if constexpr (SP2) {
        PG8_STAGE(PG8_SB(0, 0), cB, voffB); PG8_STAGE(PG8_SB(0, 1), cB + hstep, voffB); PG8_STAGE(PG8_SA(0, 0), cA, voffA); PG8_STAGE(PG8_SA(0, 1), cA + hstep, voffA);
        if (wr == 1) PG8_BAR;
        PG8_WAIT_V(2); PG8_BAR;
        PG8_STAGE(PG8_SB(1, 0), cB + kstep, voffB); PG8_STAGE(PG8_SA(1, 0), cA + kstep, voffA); PG8_STAGE(PG8_SB(1, 1), cB + hstep + kstep, voffB);
        PG8_WAIT_V(6); PG8_BAR;
    } else {
        PG8_STAGE(PG8_SB(0, 0), cB, voffB); PG8_STAGE(PG8_SA(0, 0), cA, voffA); PG8_STAGE(PG8_SB(0, 1), cB + hstep, voffB); PG8_STAGE(PG8_SA(0, 1), cA + hstep, voffA);
        if (wr == 1) PG8_BAR;
        PG8_WAIT_V(4); PG8_BAR;
        PG8_STAGE(PG8_SB(1, 0), cB + kstep, voffB); PG8_STAGE(PG8_SA(1, 0), cA + kstep, voffA); PG8_STAGE(PG8_SB(1, 1), cB + hstep + kstep, voffB);
        PG8_WAIT_V(6); PG8_BAR;
    }
    for (;;) {
        const bool has_next = S.next(ui + 1, nxt);
        const char* nA = has_next ? (const char*)g.A + (size_t)nxt.pm * tstep : cA; const char* nB = has_next ? (const char*)g.Bt + (size_t)nxt.pn * tstep : cB;
        for (int t = 0; t < nt; t += 2) {
            const bool last = (t == nt - 2);
            const char* a1 = cA + (size_t)(t + 1) * kstep;
            const char* a2 = last ? nA : cA + (size_t)(t + 2) * kstep; const char* b2 = last ? nB : cB + (size_t)(t + 2) * kstep;
            const char* a3 = a2 + kstep; const char* b3 = b2 + kstep;
            if (last && has_next) S.a_ready(nxt);
            if constexpr (SP2) {
            PG8_LDB(B0, 0, 0); PG8_LDB(B1, 0, 1); PG8_SCHED; PG8_LDA(At, 0, 0); PG8_STAGE(PG8_SA(1, 1), a1 + hstep, voffA);
            PG8_WAIT_V(8); PG8_WAIT_L(0); PG8_BAR; PG8_MMA(0, 0, At, B0); PG8_MMA(0, 1, At, B1); PG8_BAR; PG8_SCHED;
            PG8_LDA(At, 0, 1); PG8_STAGE(PG8_SB(0, 0), b2, voffB); PG8_STAGE(PG8_SB(0, 1), b2 + hstep, voffB); PG8_STAGE(PG8_SA(0, 0), a2, voffA);
            PG8_WAIT_V(8); PG8_WAIT_L(0); PG8_BAR; PG8_MMA(1, 0, At, B0); PG8_MMA(1, 1, At, B1); PG8_BAR; PG8_SCHED;
            PG8_LDB(B0, 1, 0); PG8_LDB(B1, 1, 1); PG8_SCHED; PG8_LDA(At, 1, 0); PG8_STAGE(PG8_SA(0, 1), a2 + hstep, voffA);
            PG8_WAIT_V(8); PG8_WAIT_L(0); PG8_BAR; PG8_MMA(0, 0, At, B0); PG8_MMA(0, 1, At, B1); PG8_BAR; PG8_SCHED;
            PG8_LDA(At, 1, 1); PG8_STAGE(PG8_SB(1, 0), b3, voffB); PG8_STAGE(PG8_SB(1, 1), b3 + hstep, voffB); PG8_STAGE(PG8_SA(1, 0), a3, voffA);
            PG8_WAIT_V(8); PG8_WAIT_L(0); PG8_BAR; PG8_MMA(1, 0, At, B0); PG8_MMA(1, 1, At, B1); PG8_BAR; PG8_SCHED;
            } else {
            PG8_LDB(B0, 0, 0); PG8_SCHED; PG8_LDA(At, 0, 0); PG8_STAGE(PG8_SA(1, 1), a1 + hstep, voffA);
            PG8_WAIT_L(8); PG8_BAR; PG8_WAIT_L(0); PG8_MMA(0, 0, At, B0); PG8_BAR; PG8_SCHED;
            PG8_LDB(B1, 0, 1); PG8_STAGE(PG8_SB(0, 0), b2, voffB);
            PG8_BAR; PG8_WAIT_L(0); PG8_MMA(0, 1, At, B1); PG8_BAR;
            PG8_LDA(At, 0, 1); PG8_STAGE(PG8_SA(0, 0), a2, voffA);
            PG8_BAR; PG8_WAIT_L(0); PG8_MMA(1, 0, At, B0); PG8_BAR; PG8_SCHED;
            PG8_STAGE(PG8_SB(0, 1), b2 + hstep, voffB);
            PG8_WAIT_V(6); PG8_BAR; PG8_MMA(1, 1, At, B1); PG8_BAR;
            PG8_LDB(B0, 1, 0); PG8_SCHED; PG8_LDA(At, 1, 0); PG8_STAGE(PG8_SA(0, 1), a2 + hstep, voffA);
            PG8_WAIT_L(8); PG8_BAR; PG8_WAIT_L(0); PG8_MMA(0, 0, At, B0); PG8_BAR; PG8_SCHED;
            PG8_LDB(B1, 1, 1); PG8_STAGE(PG8_SB(1, 0), b3, voffB);
            PG8_BAR; PG8_WAIT_L(0); PG8_MMA(0, 1, At, B1); PG8_BAR;
            PG8_LDA(At, 1, 1); PG8_STAGE(PG8_SA(1, 0), a3, voffA);
            PG8_BAR; PG8_WAIT_L(0); PG8_MMA(1, 0, At, B0); PG8_BAR; PG8_SCHED;
            PG8_STAGE(PG8_SB(1, 1), b3 + hstep, voffB);
            PG8_WAIT_V(6); PG8_BAR; PG8_MMA(1, 1, At, B1); PG8_BAR;
            }
        }
        if constexpr (ALIGN_EPI) { if (wr == 0) PG8_BAR; }
        if constexpr (!Epi::AFTER_DRAIN) { E(acc, cur, wr, wc, fr, fq); S.done(cur); }
        if (!has_next) break;
#pragma unroll
        for (int a = 0; a < 2; ++a)
#pragma unroll
            for (int b = 0; b < 2; ++b)
#pragma unroll
                for (int m = 0; m < 4; ++m)
#pragma unroll
                    for (int n = 0; n < 2; ++n) acc[a][b][m][n] = (f32x4){0.f, 0.f, 0.f, 0.f};
        cur = nxt; cA = nA; cB = nB; ++ui;
        if constexpr (ALIGN_EPI) { if (wr == 1) PG8_BAR; }
    }
    PG8_WAIT_V(0);
    if constexpr (!ALIGN_EPI) { if (wr == 0) PG8_BAR; }
    PG8_BAR;
    if constexpr (Epi::AFTER_DRAIN) { E.fused(acc, cur, wr, wc, fr, fq, lds, wid, lane); S.done(cur); }
#undef PG8_SA
#undef PG8_SB
#undef PG8_STAGE
#undef PG8_LDA
#undef PG8_LDB
#undef PG8_MMA
#undef PG8_WAIT_V
#undef PG8_WAIT_L
#undef PG8_BAR
#undef PG8_SCHED
}
}

constexpr int NWAVES = 8;
constexpr int BATCH = 16, SEQ = 4096, DM = 1024, NMETA = 16;
constexpr int MR = BATCH * SEQ;
constexpr int MT = MR + 256;
constexpr int IN_W = 8712, NIN = 8704;
constexpr int GATE_COL = 4608;
constexpr float RMS_EPS = 1e-6f, LN_EPS = 1e-6f;
constexpr int PER_PHASE = 9;
constexpr int N_LAUNCHES = MK_ONE_LAUNCH ? 1 : PER_PHASE;

constexpr size_t MiB = 1u << 20;
constexpr size_t WS_CTL = 0, CTL_ZERO_BYTES = 1 * MiB;
constexpr size_t WS_W1T = 2 * MiB, WS_WAO = 19 * MiB, WS_WMO = 21 * MiB, WS_WOUT = 23 * MiB;
constexpr size_t WS_ROPE = 25 * MiB;
constexpr size_t WS_IF = 26 * MiB;
constexpr size_t WS_U = 32 * MiB;
constexpr size_t WS_KV = 161 * MiB;
constexpr size_t WS_MQK = 226 * MiB;
constexpr size_t WS_MV = 355 * MiB;
constexpr size_t WS_Q = 484 * MiB;
constexpr size_t WS_AZ = 612 * MiB;
constexpr size_t WS_MO = 740 * MiB;
constexpr size_t WS_MZ = 868 * MiB;
constexpr size_t WS_OUTF = WS_MO;
constexpr size_t WS_END = 996 * MiB;
constexpr int CW_TMO = 0, CW_CODE = 1;
constexpr int CW_BAR = 4096;

constexpr int RING_OFF = 0, RING_BYTES = 135168;
constexpr int LDSCTL_OFF = RING_BYTES, MISC_OFF = LDSCTL_OFF + 320;
constexpr int LDS_BYTES = 147456;
static_assert(MISC_OFF + 128 <= LDS_BYTES, "LDS map");

#define GAS __attribute__((address_space(1)))
#define LAS __attribute__((address_space(3)))
typedef unsigned short bf16;
typedef unsigned v4u __attribute__((ext_vector_type(4)));
typedef float f32x4 __attribute__((ext_vector_type(4)));
typedef short bf16x8 __attribute__((ext_vector_type(8)));
typedef GAS unsigned gu32;
typedef GAS unsigned long long gu64;
#define RLX_AGENT __ATOMIC_RELAXED, __HIP_MEMORY_SCOPE_AGENT
#define LDS_WAIT() asm volatile("s_waitcnt lgkmcnt(0)" ::: "memory")
#define VM_WAIT() asm volatile("s_waitcnt vmcnt(0)" ::: "memory")
__device__ __forceinline__ unsigned long long rt() { return __builtin_amdgcn_s_memrealtime(); }
__device__ __forceinline__ unsigned f2bf(float f) { unsigned u = __builtin_bit_cast(unsigned, f); return (u + 0x7fffu + ((u >> 16) & 1u)) >> 16; }
__device__ __forceinline__ unsigned pk2(float lo, float hi) { return f2bf(lo) | (f2bf(hi) << 16); }

#define XB_TMO      128
#define XB_XCNT(j)  (256  + 64 * (j))
#define XB_XSUB(j)  (1280 + 64 * (j))
#define XB_XGEN(j)  (2304 + 64 * (j))
#define XB_TOP      3328
#define XB_TOPGEN   3392
#define XCD_BAR_WORDS 3456
#define XB_SPIN_CAP (1u << 18)

__device__ __forceinline__ unsigned xb_ld(unsigned* p)              { return __hip_atomic_load(p, __ATOMIC_RELAXED, __HIP_MEMORY_SCOPE_AGENT); }
__device__ __forceinline__ unsigned xb_add(unsigned* p, unsigned v) { return __hip_atomic_fetch_add(p, v, __ATOMIC_RELAXED, __HIP_MEMORY_SCOPE_AGENT); }
__device__ __forceinline__ unsigned xb_xcc_id() { return (unsigned)__builtin_amdgcn_s_getreg((3 << 11) | 20) & 0xFu; }
#define XB_SPIN(cond, bar) do { unsigned _sp = 0; while (cond) { __builtin_amdgcn_s_sleep(1); \
    if ((++_sp & 255u) == 0u) { if (xb_ld(&(bar)[XB_TMO])) break; if (_sp > XB_SPIN_CAP) { atomicAdd(&(bar)[XB_TMO], 1u); break; } } } } while (0)

struct XcdBarrier {
    unsigned* bar; unsigned x;
    volatile LAS unsigned* st;
};

__device__ __forceinline__ XcdBarrier xcd_barrier_post(unsigned* bar, volatile LAS unsigned* st) {
    XcdBarrier b; b.bar = bar; b.x = xb_xcc_id(); b.st = st;
    if (threadIdx.x == 0) (void)xb_add(&bar[XB_XCNT(b.x)], 1u);
    return b;
}
__device__ __forceinline__ void xcd_barrier_complete(unsigned* bar, unsigned x, unsigned& nloc, unsigned& nx) {
    const unsigned G = gridDim.x * gridDim.y * gridDim.z;
    unsigned sum, cnt, mine, sp = 0u;
    for (;;) {
        sum = 0u; cnt = 0u; mine = 0u;
#pragma unroll
        for (unsigned j = 0; j < 16; ++j) { const unsigned c = xb_ld(&bar[XB_XCNT(j)]); sum += c; cnt += (c > 0u) ? 1u : 0u; mine = (j == x) ? c : mine; }
        if (sum == G) break;
        __builtin_amdgcn_s_sleep(1);
        if ((++sp & 255u) == 0u) { if (xb_ld(&bar[XB_TMO])) break; if (sp > XB_SPIN_CAP) { atomicAdd(&bar[XB_TMO], 1u); break; } }
    }
    nloc = mine > 0u ? mine : 1u; nx = cnt > 0u ? cnt : 1u;
}

__device__ __forceinline__ void xcd_barrier(const XcdBarrier& b) {
    asm volatile("s_waitcnt vmcnt(0)" ::: "memory");
    __syncthreads();
    if (threadIdx.x == 0) {
        unsigned* bar = b.bar;
        __builtin_amdgcn_s_waitcnt(0);
        unsigned nloc = b.st[0], nx = b.st[1];
        if (nloc == 0u) { xcd_barrier_complete(bar, b.x, nloc, nx); b.st[0] = nloc; b.st[1] = nx; }
        const unsigned old = xb_add(&bar[XB_XSUB(b.x)], 1u);
        const unsigned gen = old / nloc;
        if (old + 1u == (gen + 1u) * nloc) {
            __builtin_amdgcn_fence(__ATOMIC_RELEASE, "agent");
            asm volatile("s_waitcnt vmcnt(0)" ::: "memory");
            const unsigned og = xb_add(&bar[XB_TOP], 1u);
            const unsigned tg = og / nx;
            if (og + 1u == (tg + 1u) * nx) xb_add(&bar[XB_TOPGEN], 1u);
            else XB_SPIN(xb_ld(&bar[XB_TOPGEN]) == tg, bar);
            __builtin_amdgcn_fence(__ATOMIC_ACQUIRE, "agent");
            xb_add(&bar[XB_XGEN(b.x)], 1u);
            asm volatile("s_waitcnt vmcnt(0)" ::: "memory");
        } else {
            XB_SPIN(xb_ld(&bar[XB_XGEN(b.x)]) == gen, bar);
            __builtin_amdgcn_fence(__ATOMIC_ACQUIRE, "agent");
            asm volatile("s_waitcnt vmcnt(0)" ::: "memory");
        }
    }
    __syncthreads();
}

struct Frame {
    LAS unsigned char* lds;
    volatile LAS unsigned* MISC;
    gu32* ctl;
    int tid, lane, wave;
    int vcu, G;
    const float *x, *meta, *norm_pre, *w_in, *sinks, *conv_w, *conv_b, *gate_bias, *head_norm, *w_ao, *w_mo, *w_out, *norm_post;
    float* out;
    bf16 *W1T, *WAO, *WMO, *WOUT;
    float *ROPE, *IF, *OUTF;
    bf16 *U, *KV, *MQK, *MV, *Q, *AZ, *MO, *MZ, *GA, *GM;
};
__device__ __forceinline__ float wave_sum(float v) {
#pragma unroll
    for (int o = 1; o < 64; o <<= 1) v += __shfl_xor(v, o);
    return v;
}
__device__ __forceinline__ float wave_max(float v) {
#pragma unroll
    for (int o = 1; o < 64; o <<= 1) v = fmaxf(v, __shfl_xor(v, o));
    return v;
}
__device__ __forceinline__ float bf2f(bf16 v) { return __uint_as_float((unsigned)v << 16); }
__device__ __forceinline__ float bflo(unsigned w) { return __uint_as_float(w << 16); }
__device__ __forceinline__ float bfhi(unsigned w) { return __uint_as_float(w & 0xffff0000u); }

__device__ __forceinline__ void p0_transpose_item(const float* W, int ldw, int K, bf16* WT, LAS float* scr, int nblk, int item, int lane, bool skipgate) {
    const int kb = item / nblk, nb = item % nblk, k0 = 64 * kb, n0 = 32 * nb;
    const int shift = (skipgate && n0 >= GATE_COL) ? 8 : 0;
#pragma unroll 8
    for (int i = 0; i < 32; ++i) { const int kk = 2 * i + (lane >> 5); scr[kk * 33 + (lane & 31)] = W[(size_t)(k0 + kk) * ldw + n0 + shift + (lane & 31)]; }
    LDS_WAIT(); asm volatile("" ::: "memory");
    const int c = lane & 7;
#pragma unroll
    for (int j = 0; j < 4; ++j) { const int n = (lane >> 3) + 8 * j; const LAS float* s = scr + (8 * c) * 33 + n;
        v4u o; o.x = pk2(s[0 * 33], s[1 * 33]); o.y = pk2(s[2 * 33], s[3 * 33]); o.z = pk2(s[4 * 33], s[5 * 33]); o.w = pk2(s[6 * 33], s[7 * 33]);
        *(GAS v4u*)(WT + (size_t)(n0 + n) * K + k0 + 8 * c) = o; }
    LDS_WAIT(); asm volatile("" ::: "memory");
}
__device__ __forceinline__ void p0_prologue(Frame& F) {
    LAS float* scr = (LAS float*)(F.lds + RING_OFF + F.wave * 16384);
    const int gw = F.vcu * NWAVES + F.wave, NGW = F.G * NWAVES, lane = F.lane;
    constexpr int I_IN = (DM / 64) * (NIN / 32), I_SQ = (DM / 64) * (DM / 32);
    constexpr int NITEMS = I_IN + 3 * I_SQ;
    for (int it = gw; it < NITEMS; it += NGW) {
        int r = it;
        if (r < I_IN) { p0_transpose_item(F.w_in, IN_W, DM, F.W1T, scr, NIN / 32, r, lane, true); continue; } r -= I_IN;
        if (r < I_SQ) { p0_transpose_item(F.w_ao, DM, DM, F.WAO, scr, DM / 32, r, lane, false); continue; } r -= I_SQ;
        if (r < I_SQ) { p0_transpose_item(F.w_mo, DM, DM, F.WMO, scr, DM / 32, r, lane, false); continue; } r -= I_SQ;
        p0_transpose_item(F.w_out, DM, DM, F.WOUT, scr, DM / 32, r, lane, false);
    }
    {
        const int gt = F.vcu * (NWAVES * 64) + F.tid, NGT = F.G * NWAVES * 64;
        for (int idx = gt; idx < (SEQ + NMETA) * 8; idx += NGT) {
            const int pos = idx >> 3, i = idx & 7;
            const float invf = (i == 0) ? 1.0f : (i == 1) ? 0.1939227432012558f : (i == 2) ? 0.03760603070259094f : (i == 3) ? 0.007292664609849453f :
                               (i == 4) ? 0.0014142135623842478f : (i == 5) ? 0.00027424818836152554f : (i == 6) ? 5.318296098266728e-05f : 1.0313386155758053e-05f;
            const float ang = (float)pos * invf;
            double rev = (double)ang * 0.15915494309189535; rev -= floor(rev);
            const float rf = (float)rev;
            F.ROPE[(size_t)pos * 16 + i] = __builtin_amdgcn_cosf(rf);
            F.ROPE[(size_t)pos * 16 + 8 + i] = __builtin_amdgcn_sinf(rf);
        }
    }
    {
        f32x4 wg[4][4][2];
#pragma unroll
        for (int j = 0; j < 4; ++j)
#pragma unroll
            for (int i = 0; i < 4; ++i) { const float* p = F.w_in + (size_t)(256 * j + 4 * lane + i) * IN_W + GATE_COL; wg[j][i][0] = *(const f32x4*)p; wg[j][i][1] = *(const f32x4*)(p + 4); }
        f32x4 gp[4];
#pragma unroll
        for (int j = 0; j < 4; ++j) gp[j] = *(const f32x4*)(F.norm_pre + 256 * j + 4 * lane);
        for (int m = gw; m < MT; m += NGW) {
            GAS unsigned long long* o8 = (GAS unsigned long long*)(F.U + (size_t)m * DM) + lane;
            if (m >= MR + NMETA) {
#pragma unroll
                for (int j = 0; j < 4; ++j) o8[64 * j] = 0ull;
                continue;
            }
            const float* xrow = (m < MR) ? F.x + (size_t)m * DM : F.meta + (size_t)(m - MR) * DM;
            const GAS f32x4* xr = (const GAS f32x4*)xrow + lane;
            f32x4 v[4]; float s = 0.f;
#pragma unroll
            for (int j = 0; j < 4; ++j) { v[j] = xr[64 * j]; s += (v[j].x * v[j].x + v[j].y * v[j].y) + (v[j].z * v[j].z + v[j].w * v[j].w); }
            const float rstd = 1.0f / sqrtf(wave_sum(s) * (1.f / DM) + RMS_EPS);
            f32x4 ga = {0.f, 0.f, 0.f, 0.f}, gb = {0.f, 0.f, 0.f, 0.f};
#pragma unroll
            for (int j = 0; j < 4; ++j) {
                v[j] = v[j] * rstd * gp[j];
                o8[64 * j] = (unsigned long long)pk2(v[j].x, v[j].y) | ((unsigned long long)pk2(v[j].z, v[j].w) << 32);
#pragma unroll
                for (int i = 0; i < 4; ++i) { ga += wg[j][i][0] * v[j][i]; gb += wg[j][i][1] * v[j][i]; }
            }
            float g8[8];
#pragma unroll
            for (int c = 0; c < 4; ++c) { g8[c] = wave_sum(ga[c]); g8[4 + c] = wave_sum(gb[c]); }
            if (lane < 8) {
                float val = 0.f;
#pragma unroll
                for (int c = 0; c < 8; ++c) val = (lane == c) ? g8[c] : val;
                val += F.gate_bias[lane];
                if (lane >= 4) { val = fminf(val, 0.f) - log1pf(__expf(-fabsf(val))); }
                F.IF[(size_t)m * 8 + lane] = val;
            }
        }
    }
}

__device__ __forceinline__ void attn_unit_simple(Frame& F, int unit) {
    const int b = unit >> 7, rem = unit & 127, qblk = rem >> 2, kvh = rem & 3;
    LAS bf16* Ks = (LAS bf16*)(F.lds + RING_OFF);
    LAS bf16* Vs = Ks + 272 * 64;
    const int tid = F.tid;
    __syncthreads();
    for (int c = tid; c < 272 * 8 * 2; c += NWAVES * 64) {
        const int isv = c / (272 * 8), cc = c % (272 * 8), j = cc >> 3, ch = cc & 7;
        v4u val = {0u, 0u, 0u, 0u};
        long row = -1;
        if (j < 16) row = MR + j;
        else { const int sidx = qblk * 128 - 128 + (j - 16); if (sidx >= 0) row = (long)b * SEQ + sidx; }
        if (row >= 0) val = *(const GAS v4u*)(F.KV + (size_t)row * 512 + isv * 256 + kvh * 64 + ch * 8);
        *(LAS v4u*)((isv ? Vs : Ks) + j * 64 + ch * 8) = val;
    }
    __syncthreads();
    const int g = tid >> 7, qi = tid & 127, head = kvh * 4 + g;
    const size_t qrow = (size_t)b * SEQ + qblk * 128 + qi;
    float q[64], o[64];
    {
        const GAS v4u* qp = (const GAS v4u*)(F.Q + qrow * DM + head * 64);
#pragma unroll
        for (int c = 0; c < 8; ++c) { const v4u w = qp[c];
            q[8 * c + 0] = bflo(w.x); q[8 * c + 1] = bfhi(w.x); q[8 * c + 2] = bflo(w.y); q[8 * c + 3] = bfhi(w.y);
            q[8 * c + 4] = bflo(w.z); q[8 * c + 5] = bfhi(w.z); q[8 * c + 6] = bflo(w.w); q[8 * c + 7] = bfhi(w.w); }
    }
#pragma unroll
    for (int d = 0; d < 64; ++d) o[d] = 0.f;
    float mx = F.sinks[head], l = 1.0f;
    for (int j = 0; j < 272; ++j) {
        bool valid;
        if (j < 16) valid = true;
        else { const int kj = j - 16; valid = (kj > qi) && (kj <= qi + 128) && (qblk * 128 + kj - 128 >= 0); }
        if (valid) {
            float s = 0.f;
#pragma unroll
            for (int c = 0; c < 8; ++c) { const v4u w = *(const LAS v4u*)(Ks + j * 64 + c * 8);
                s += q[8 * c + 0] * bflo(w.x) + q[8 * c + 1] * bfhi(w.x) + q[8 * c + 2] * bflo(w.y) + q[8 * c + 3] * bfhi(w.y)
                   + q[8 * c + 4] * bflo(w.z) + q[8 * c + 5] * bfhi(w.z) + q[8 * c + 6] * bflo(w.w) + q[8 * c + 7] * bfhi(w.w); }
            const float mn = fmaxf(mx, s), al = __expf(mx - mn), p = __expf(s - mn);
            l = l * al + p; mx = mn;
#pragma unroll
            for (int c = 0; c < 8; ++c) { const v4u w = *(const LAS v4u*)(Vs + j * 64 + c * 8);
                o[8 * c + 0] = o[8 * c + 0] * al + p * bflo(w.x); o[8 * c + 1] = o[8 * c + 1] * al + p * bfhi(w.x);
                o[8 * c + 2] = o[8 * c + 2] * al + p * bflo(w.y); o[8 * c + 3] = o[8 * c + 3] * al + p * bfhi(w.y);
                o[8 * c + 4] = o[8 * c + 4] * al + p * bflo(w.z); o[8 * c + 5] = o[8 * c + 5] * al + p * bfhi(w.z);
                o[8 * c + 6] = o[8 * c + 6] * al + p * bflo(w.w); o[8 * c + 7] = o[8 * c + 7] * al + p * bfhi(w.w); }
        }
    }
    const float rl = 1.0f / l;
    const GAS v4u* zp = (const GAS v4u*)(F.AZ + qrow * DM + head * 64);
    GAS v4u* op = (GAS v4u*)(F.Q + qrow * DM + head * 64);
#pragma unroll
    for (int c = 0; c < 8; ++c) { const v4u z = zp[c]; v4u w;
        w.x = pk2(o[8 * c + 0] * rl * bflo(z.x), o[8 * c + 1] * rl * bfhi(z.x)); w.y = pk2(o[8 * c + 2] * rl * bflo(z.y), o[8 * c + 3] * rl * bfhi(z.y));
        w.z = pk2(o[8 * c + 4] * rl * bflo(z.z), o[8 * c + 5] * rl * bfhi(z.z)); w.w = pk2(o[8 * c + 6] * rl * bflo(z.w), o[8 * c + 7] * rl * bfhi(z.w));
        op[c] = w; }
}

__device__ __forceinline__ long seqrow(int b, int p) { return p < NMETA ? (long)MR + p : (long)b * SEQ + (p - NMETA); }
typedef unsigned u32x4_t __attribute__((ext_vector_type(4)));
__device__ __forceinline__ void conv_prepass(Frame& F) {
    const int gt = F.vcu * (NWAVES * 64) + F.tid, ch = gt & 127, c0 = 8 * ch;
    float w[4][8], bias[8];
#pragma unroll
    for (int e = 0; e < 8; ++e) { bias[e] = F.conv_b[c0 + e];
#pragma unroll
        for (int j = 0; j < 4; ++j) w[j][e] = F.conv_w[j * 1024 + c0 + e]; }
    const float osc = (ch >= 64) ? 0.08838834764831845f : 1.0f;
    const int rstep = (F.G * NWAVES * 64) >> 7;
    for (int r = gt >> 7; r < MR + NMETA; r += rstep) {
        float a[8];
#pragma unroll
        for (int e = 0; e < 8; ++e) a[e] = bias[e];
        const int s = r & 4095;
#pragma unroll
        for (int j = 0; j < 4; ++j) {
            long row;
            if (r < MR) { const int ss = s - 3 + j; row = (ss >= 0) ? (long)(r - 3 + j) : (long)MR + 16 + ss; }
            else { const int pp = (r - MR) - 3 + j; row = (pp >= 0) ? (long)MR + pp : -1; }
            if (row >= 0) { const v4u x = *(const GAS v4u*)(F.MQK + (size_t)row * DM + c0);
                a[0] += w[j][0] * bflo(x.x); a[1] += w[j][1] * bfhi(x.x); a[2] += w[j][2] * bflo(x.y); a[3] += w[j][3] * bfhi(x.y);
                a[4] += w[j][4] * bflo(x.z); a[5] += w[j][5] * bfhi(x.z); a[6] += w[j][6] * bflo(x.w); a[7] += w[j][7] * bfhi(x.w); }
        }
#pragma unroll
        for (int e = 0; e < 8; ++e) a[e] = a[e] / (1.0f + __expf(-a[e])) * osc;
        v4u o; o.x = pk2(a[0], a[1]); o.y = pk2(a[2], a[3]); o.z = pk2(a[4], a[5]); o.w = pk2(a[6], a[7]);
        *(GAS v4u*)(F.U + (size_t)r * DM + c0) = o;
    }
}

namespace ml {
using bf16x8 = __attribute__((ext_vector_type(8))) short;
using s16x4 = __attribute__((ext_vector_type(4))) short;
using f32x16 = __attribute__((ext_vector_type(16))) float;
typedef short v4i16_t __attribute__((ext_vector_type(4)));
typedef float f32x2_t __attribute__((ext_vector_type(2))); typedef __bf16 bf16x2_t __attribute__((ext_vector_type(2)));
__device__ __forceinline__ unsigned cvtpk(float lo, float hi) { f32x2_t v = {lo, hi}; bf16x2_t b = __builtin_convertvector(v, bf16x2_t); return __builtin_bit_cast(unsigned, b); }
__device__ __forceinline__ s16x4 trr(const LAS unsigned char* p) { return __builtin_bit_cast(s16x4, __builtin_amdgcn_ds_read_tr16_b64_v4i16((LAS v4i16_t*)p)); }
__device__ __forceinline__ bf16x8 cat8(s16x4 a, s16x4 b) { return (bf16x8){a[0], a[1], a[2], a[3], b[0], b[1], b[2], b[3]}; }
__device__ __forceinline__ int crow(int r, int hi) { return (r & 3) + 8 * (r >> 2) + 4 * hi; }
constexpr int QSTR = 272, VSTR = 192;
constexpr int L_QS = 0, L_KS = L_QS + 64 * QSTR, L_VS = L_KS + 64 * QSTR, L_WVS = L_VS + 64 * VSTR, L_XT = L_WVS + 64 * VSTR, L_G = L_XT + 64 * QSTR;
constexpr int G_CS = 0, G_RT = 64, G_WI = 128, G_EI = 192, G_WA = 256, G_WC = 320, G_SZ = 324;
constexpr int L_N = L_G + 2 * G_SZ * 4, L_SCR = L_N + 2 * 128 * 4, L_END = L_SCR + 4 * 32 * 4;
static_assert(L_END <= RING_BYTES, "mLSTM LDS map");

__device__ __forceinline__ void sc_tile(f32x16& st, const LAS float* cs, float rtv, int r32, int hi, bool diag, float& rs) {
#pragma unroll
    for (int g = 0; g < 4; ++g) { const f32x4 c4 = *(const LAS f32x4*)(cs + 8 * g + 4 * hi);
#pragma unroll
        for (int e = 0; e < 4; ++e) { const int reg = 4 * g + e; float v = st[reg] * __expf(c4[e] + rtv);
            if (diag && (8 * g + 4 * hi + e) > r32) v = 0.f;
            st[reg] = v; rs += v; } }
}

__device__ __forceinline__ void mlstm_chain(Frame& F, int chain) {
    const int b = chain >> 4, h = (chain >> 2) & 3, vsl = chain & 3;
    const int tid = F.tid, lane = F.lane, wid = F.wave, r32 = lane & 31, hi = lane >> 5, g4 = lane >> 4, i16 = lane & 15;
    LAS unsigned char* L = F.lds + RING_OFF;
    LAS float* GB = (LAS float*)(L + L_G);
    LAS float* NB = (LAS float*)(L + L_N);
    LAS float* SCR = (LAS float*)(L + L_SCR);
    const bf16* QKc = F.U;
    v4u pq[2], pk[2], pv;
    float m_carry = 0.f;
#define ML_PREFETCH(cn) do { \
        _Pragma("unroll") for (int i_ = 0; i_ < 2; ++i_) { const int idx_ = tid + 512 * i_, t_ = idx_ >> 4, pc_ = idx_ & 15, p_ = 64 * (cn) - 48 + t_; \
            if (p_ >= 0) { const size_t ro_ = (size_t)seqrow(b, p_) * DM + h * 128 + 8 * pc_; pq[i_] = *(const GAS v4u*)(QKc + ro_); pk[i_] = *(const GAS v4u*)(QKc + ro_ + 512); } \
            else { pq[i_] = (v4u){0u, 0u, 0u, 0u}; pk[i_] = (v4u){0u, 0u, 0u, 0u}; } } \
        { const int t_ = tid >> 3, pc_ = tid & 7, p_ = 64 * (cn) - 48 + t_; \
            if (p_ >= 0) pv = *(const GAS v4u*)(F.MV + (size_t)seqrow(b, p_) * DM + h * 256 + vsl * 64 + 8 * pc_); else pv = (v4u){0u, 0u, 0u, 0u}; } } while (0)
#define ML_STAGE(gb) do { \
        _Pragma("unroll") for (int i_ = 0; i_ < 2; ++i_) { const int idx_ = tid + 512 * i_, t_ = idx_ >> 4, pc_ = idx_ & 15; \
            *(LAS v4u*)(L + L_QS + t_ * QSTR + pc_ * 16) = pq[i_]; *(LAS v4u*)(L + L_KS + t_ * QSTR + pc_ * 16) = pk[i_]; } \
        { const int t_ = tid >> 3, pc_ = tid & 7; const float wa_ = (gb)[G_WA + t_]; \
            *(LAS v4u*)(L + L_VS + t_ * VSTR + pc_ * 16) = pv; v4u s_; \
            s_.x = cvtpk(bflo(pv.x) * wa_, bfhi(pv.x) * wa_); s_.y = cvtpk(bflo(pv.y) * wa_, bfhi(pv.y) * wa_); \
            s_.z = cvtpk(bflo(pv.z) * wa_, bfhi(pv.z) * wa_); s_.w = cvtpk(bflo(pv.w) * wa_, bfhi(pv.w) * wa_); \
            *(LAS v4u*)(L + L_WVS + t_ * VSTR + pc_ * 16) = s_; } } while (0)
#define ML_GATES(cn, gb) do { const int p_ = 64 * (cn) - 48 + lane; float li_ = -1e30f, lf_ = 0.f; \
        if (p_ >= 0) { const float* ip_ = F.IF + (size_t)seqrow(b, p_) * 8; li_ = ip_[h]; lf_ = ip_[4 + h]; } \
        float bc_ = lf_; \
        _Pragma("unroll") for (int o_ = 1; o_ < 64; o_ <<= 1) { const float u_ = __shfl_up(bc_, o_); if (lane >= o_) bc_ += u_; } \
        const float cv_ = li_ - bc_; float pm_ = cv_; \
        _Pragma("unroll") for (int o_ = 1; o_ < 64; o_ <<= 1) { const float u_ = __shfl_up(pm_, o_); if (lane >= o_) pm_ = fmaxf(pm_, u_); } \
        const float bl_ = __shfl(bc_, 63), pmx_ = __shfl(pm_, 63); \
        const float mnew_ = fmaxf(bl_ + m_carry, bl_ + pmx_); \
        const float rt_ = -fmaxf(m_carry, pm_); \
        (gb)[G_CS + lane] = cv_; (gb)[G_RT + lane] = rt_; (gb)[G_WI + lane] = __expf(m_carry + rt_); (gb)[G_EI + lane] = __expf(rt_ - bc_); \
        (gb)[G_WA + lane] = __expf(bl_ + cv_ - mnew_); if (lane == 0) (gb)[G_WC] = __expf(bl_ + m_carry - mnew_); \
        m_carry = mnew_; } while (0)

    f32x16 ax0, ax1;
#pragma unroll
    for (int r = 0; r < 16; ++r) { ax0[r] = 0.f; ax1[r] = 0.f; }
    __syncthreads();
    for (int i = tid; i < 64 * QSTR / 16; i += NWAVES * 64) *(LAS v4u*)(L + L_XT + i * 16) = (v4u){0u, 0u, 0u, 0u};
    if (tid < 128) NB[tid] = 0.f;
    if (wid == 6) ML_GATES(0, GB);
    ML_PREFETCH(0);
    __syncthreads();
    ML_STAGE(GB);
    __syncthreads();
    for (int c = 0; c < 65; ++c) {
        LAS float* gcur = GB + (c & 1) * G_SZ; LAS float* gnxt = GB + ((c & 1) ^ 1) * G_SZ;
        LAS float* ncur = NB + (c & 1) * 128;  LAS float* nnxt = NB + ((c & 1) ^ 1) * 128;
        if (c < 64) ML_PREFETCH(c + 1);
        if (wid < 4) {
            const int tb = wid >> 1, vb = wid & 1;
            bf16x8 qf[8];
            { const LAS unsigned char* qrow = L + L_QS + (32 * tb + r32) * QSTR + hi * 16;
#pragma unroll
              for (int kk = 0; kk < 8; ++kk) qf[kk] = *(const LAS bf16x8*)(qrow + kk * 32); }
            f32x16 acc, st0, st1;
#pragma unroll
            for (int r = 0; r < 16; ++r) { acc[r] = 0.f; st0[r] = 0.f; st1[r] = 0.f; }
            { const LAS unsigned char* xrow = L + L_XT + (32 * vb + r32) * QSTR + hi * 16;
#pragma unroll
              for (int kk = 0; kk < 8; ++kk) acc = __builtin_amdgcn_mfma_f32_32x32x16_bf16(qf[kk], *(const LAS bf16x8*)(xrow + kk * 32), acc, 0, 0, 0); }
            { const LAS unsigned char* krow = L + L_KS + r32 * QSTR + hi * 16;
#pragma unroll
              for (int kk = 0; kk < 8; ++kk) st0 = __builtin_amdgcn_mfma_f32_32x32x16_bf16(*(const LAS bf16x8*)(krow + kk * 32), qf[kk], st0, 0, 0, 0);
              if (tb == 1) {
#pragma unroll
                  for (int kk = 0; kk < 8; ++kk) st1 = __builtin_amdgcn_mfma_f32_32x32x16_bf16(*(const LAS bf16x8*)(krow + 32 * QSTR + kk * 32), qf[kk], st1, 0, 0, 0); } }
            const int t = 32 * tb + r32;
            const float rtv = gcur[G_RT + t];
            float rs = 0.f;
            if (tb == 0) sc_tile(st0, gcur + G_CS, rtv, r32, hi, true, rs);
            else { sc_tile(st0, gcur + G_CS, rtv, r32, hi, false, rs); sc_tile(st1, gcur + G_CS + 32, rtv, r32, hi, true, rs); }
            rs += __shfl_xor(rs, 32);
            float qn = 0.f;
#pragma unroll
            for (int kk = 0; kk < 8; ++kk) { const f32x4 n0 = *(const LAS f32x4*)(ncur + 16 * kk + 8 * hi), n1 = *(const LAS f32x4*)(ncur + 16 * kk + 8 * hi + 4);
#pragma unroll
                for (int j = 0; j < 4; ++j) { qn += __uint_as_float((unsigned)(unsigned short)qf[kk][j] << 16) * n0[j]; qn += __uint_as_float((unsigned)(unsigned short)qf[kk][4 + j] << 16) * n1[j]; } }
            qn += __shfl_xor(qn, 32);
            const float den = fmaxf(fabsf(gcur[G_WI + t] * qn + rs), gcur[G_EI + t]);
            SCR[wid * 32 + r32] = 1.0f / den;
            f32x4 wi4[4], rd4[4];
#pragma unroll
            for (int g = 0; g < 4; ++g) { wi4[g] = *(const LAS f32x4*)(gcur + G_WI + 32 * tb + 8 * g + 4 * hi); rd4[g] = *(const LAS f32x4*)(SCR + wid * 32 + 8 * g + 4 * hi); }
#pragma unroll
            for (int r = 0; r < 16; ++r) acc[r] *= wi4[r >> 2][r & 3];
            {
                const LAS unsigned char* vb0 = L + L_VS + (4 * hi + (i16 >> 2)) * VSTR + (32 * vb + 16 * (g4 & 1) + 4 * (i16 & 3)) * 2;
#pragma unroll
                for (int ks = 0; ks < 2; ++ks) {
                    u32x4_t a; a.x = cvtpk(st0[8 * ks + 0], st0[8 * ks + 1]); a.y = cvtpk(st0[8 * ks + 2], st0[8 * ks + 3]); a.z = cvtpk(st0[8 * ks + 4], st0[8 * ks + 5]); a.w = cvtpk(st0[8 * ks + 6], st0[8 * ks + 7]);
                    const bf16x8 bv = cat8(trr(vb0 + (16 * ks) * VSTR), trr(vb0 + (16 * ks + 8) * VSTR));
                    acc = __builtin_amdgcn_mfma_f32_32x32x16_bf16(__builtin_bit_cast(bf16x8, a), bv, acc, 0, 0, 0);
                }
                if (tb == 1) {
#pragma unroll
                    for (int ks = 0; ks < 2; ++ks) {
                        u32x4_t a; a.x = cvtpk(st1[8 * ks + 0], st1[8 * ks + 1]); a.y = cvtpk(st1[8 * ks + 2], st1[8 * ks + 3]); a.z = cvtpk(st1[8 * ks + 4], st1[8 * ks + 5]); a.w = cvtpk(st1[8 * ks + 6], st1[8 * ks + 7]);
                        const bf16x8 bv = cat8(trr(vb0 + (32 + 16 * ks) * VSTR), trr(vb0 + (32 + 16 * ks + 8) * VSTR));
                        acc = __builtin_amdgcn_mfma_f32_32x32x16_bf16(__builtin_bit_cast(bf16x8, a), bv, acc, 0, 0, 0);
                    }
                }
            }
            if (c >= 1) {
                bf16* op = F.MV + ((size_t)b * SEQ + (size_t)(c - 1) * 64 + 32 * tb) * DM + h * 256 + vsl * 64 + 32 * vb + r32;
#pragma unroll
                for (int r = 0; r < 16; ++r) op[(size_t)crow(r, hi) * DM] = (bf16)f2bf(acc[r] * rd4[r >> 2][r & 3]);
            }
        } else {
            const int db = wid - 4;
            const float wc_ = gcur[G_WC];
#pragma unroll
            for (int r = 0; r < 16; ++r) { ax0[r] *= wc_; ax1[r] *= wc_; }
            const LAS unsigned char* ka = L + L_KS + (8 * hi + (i16 >> 2)) * QSTR + (32 * db + 16 * (g4 & 1) + 4 * (i16 & 3)) * 2;
            const LAS unsigned char* va = L + L_WVS + (8 * hi + (i16 >> 2)) * VSTR + (16 * (g4 & 1) + 4 * (i16 & 3)) * 2;
#pragma unroll
            for (int ks = 0; ks < 4; ++ks) {
                const bf16x8 af = cat8(trr(ka + (16 * ks) * QSTR), trr(ka + (16 * ks + 4) * QSTR));
                const bf16x8 b0 = cat8(trr(va + (16 * ks) * VSTR), trr(va + (16 * ks + 4) * VSTR));
                const bf16x8 b1 = cat8(trr(va + (16 * ks) * VSTR + 64), trr(va + (16 * ks + 4) * VSTR + 64));
                ax0 = __builtin_amdgcn_mfma_f32_32x32x16_bf16(af, b0, ax0, 0, 0, 0);
                ax1 = __builtin_amdgcn_mfma_f32_32x32x16_bf16(af, b1, ax1, 0, 0, 0);
            }
            if (wid == 6) { if (c < 64) ML_GATES(c + 1, gnxt); }
            if (wid == 7) {
                float a0 = 0.f, a1 = 0.f;
                for (int s = 0; s < 64; ++s) { const unsigned w = *(const LAS unsigned*)(L + L_KS + s * QSTR + lane * 4); const float was = gcur[G_WA + s]; a0 += was * bflo(w); a1 += was * bfhi(w); }
                nnxt[2 * lane] = wc_ * ncur[2 * lane] + a0; nnxt[2 * lane + 1] = wc_ * ncur[2 * lane + 1] + a1;
            }
        }
        __syncthreads();
        if (wid >= 4) {
            const int db = wid - 4;
#pragma unroll
            for (int g = 0; g < 4; ++g) {
                unsigned long long w0 = (unsigned long long)cvtpk(ax0[4 * g], ax0[4 * g + 1]) | ((unsigned long long)cvtpk(ax0[4 * g + 2], ax0[4 * g + 3]) << 32);
                unsigned long long w1 = (unsigned long long)cvtpk(ax1[4 * g], ax1[4 * g + 1]) | ((unsigned long long)cvtpk(ax1[4 * g + 2], ax1[4 * g + 3]) << 32);
                *(LAS unsigned long long*)(L + L_XT + r32 * QSTR + (32 * db + 8 * g + 4 * hi) * 2) = w0;
                *(LAS unsigned long long*)(L + L_XT + (32 + r32) * QSTR + (32 * db + 8 * g + 4 * hi) * 2) = w1;
            }
        }
        if (c < 64) ML_STAGE(gnxt);
        __syncthreads();
    }
#undef ML_PREFETCH
#undef ML_STAGE
#undef ML_GATES
}
}

__device__ __forceinline__ void p3_min(Frame& F) {
    const int gw = F.vcu * NWAVES + F.wave, NGW = F.G * NWAVES, lane = F.lane;
    for (int m = gw; m < MR; m += NGW) {
#pragma unroll
        for (int hh = 0; hh < 4; ++hh) {
            const size_t off = (size_t)m * DM + hh * 256 + 4 * lane;
            const unsigned long long cw = *(const GAS unsigned long long*)(F.MV + off), ow = *(const GAS unsigned long long*)(F.MO + off), zw = *(const GAS unsigned long long*)(F.MZ + off);
            const f32x4 gm = *(const f32x4*)(F.head_norm + hh * 256 + 4 * lane);
            float xv[4];
            xv[0] = bflo((unsigned)cw) * bflo((unsigned)ow); xv[1] = bfhi((unsigned)cw) * bfhi((unsigned)ow);
            xv[2] = bflo((unsigned)(cw >> 32)) * bflo((unsigned)(ow >> 32)); xv[3] = bfhi((unsigned)(cw >> 32)) * bfhi((unsigned)(ow >> 32));
            const float mu = wave_sum((xv[0] + xv[1]) + (xv[2] + xv[3])) * (1.f / 256.f);
            float q = 0.f;
#pragma unroll
            for (int e = 0; e < 4; ++e) { xv[e] -= mu; q += xv[e] * xv[e]; }
            const float rstd = 1.0f / sqrtf(wave_sum(q) * (1.f / 256.f) + LN_EPS);
            const float z0 = bflo((unsigned)zw), z1 = bfhi((unsigned)zw), z2 = bflo((unsigned)(zw >> 32)), z3 = bfhi((unsigned)(zw >> 32));
            const unsigned lo = pk2(xv[0] * rstd * gm[0] * z0, xv[1] * rstd * gm[1] * z1), hi = pk2(xv[2] * rstd * gm[2] * z2, xv[3] * rstd * gm[3] * z3);
            *(GAS unsigned long long*)(F.MV + off) = (unsigned long long)lo | ((unsigned long long)hi << 32);
        }
    }
}
__device__ __forceinline__ void p7_final(Frame& F) {
    const int gw = F.vcu * NWAVES + F.wave, NGW = F.G * NWAVES, lane = F.lane;
    f32x4 gp[4];
#pragma unroll
    for (int j = 0; j < 4; ++j) gp[j] = *(const f32x4*)(F.norm_post + 256 * j + 4 * lane);
    for (int m = gw; m < MR; m += NGW) {
        const GAS f32x4* yr = (const GAS f32x4*)(F.OUTF + (size_t)m * DM) + lane;
        const GAS f32x4* xr = (const GAS f32x4*)(F.x + (size_t)m * DM) + lane;
        GAS f32x4* orow = (GAS f32x4*)(F.out + (size_t)m * DM) + lane;
        f32x4 v[4], xv[4]; float s = 0.f;
#pragma unroll
        for (int j = 0; j < 4; ++j) { v[j] = yr[64 * j]; xv[j] = xr[64 * j]; s += (v[j].x * v[j].x + v[j].y * v[j].y) + (v[j].z * v[j].z + v[j].w * v[j].w); }
        const float rstd = 1.0f / sqrtf(wave_sum(s) * (1.f / DM) + RMS_EPS);
#pragma unroll
        for (int j = 0; j < 4; ++j) orow[64 * j] = xv[j] + v[j] * rstd * gp[j];
    }
}

struct Args { const float* in[13]; float* out; unsigned char* ws; int ph_lo, ph_hi, li, pad; };
__global__ void __launch_bounds__(NWAVES * 64, 2) hyb_fwd(Args args) {
    extern __shared__ __attribute__((aligned(16))) unsigned char lds[];
    Frame F;
    F.lds = (LAS unsigned char*)lds;
    F.MISC = (volatile LAS unsigned*)(F.lds + MISC_OFF);
    F.tid = threadIdx.x; F.lane = F.tid & 63; F.wave = __builtin_amdgcn_readfirstlane(F.tid >> 6);
    F.G = gridDim.x; { const int bx = blockIdx.x; F.vcu = (F.G % 8 == 0) ? (bx % 8) * (F.G / 8) + bx / 8 : bx; }
    unsigned char* ws = args.ws;
    F.ctl = (gu32*)(ws + WS_CTL);
    F.x = args.in[0]; F.meta = args.in[1]; F.norm_pre = args.in[2]; F.w_in = args.in[3]; F.sinks = args.in[4]; F.conv_w = args.in[5]; F.conv_b = args.in[6];
    F.gate_bias = args.in[7]; F.head_norm = args.in[8]; F.w_ao = args.in[9]; F.w_mo = args.in[10]; F.w_out = args.in[11]; F.norm_post = args.in[12];
    F.out = args.out;
    F.W1T = (bf16*)(ws + WS_W1T); F.WAO = (bf16*)(ws + WS_WAO); F.WMO = (bf16*)(ws + WS_WMO); F.WOUT = (bf16*)(ws + WS_WOUT);
    F.ROPE = (float*)(ws + WS_ROPE); F.IF = (float*)(ws + WS_IF); F.OUTF = (float*)(ws + WS_OUTF);
    F.U = (bf16*)(ws + WS_U); F.KV = (bf16*)(ws + WS_KV); F.MQK = (bf16*)(ws + WS_MQK); F.MV = (bf16*)(ws + WS_MV); F.Q = (bf16*)(ws + WS_Q);
    F.AZ = (bf16*)(ws + WS_AZ); F.MO = (bf16*)(ws + WS_MO); F.MZ = (bf16*)(ws + WS_MZ);
    F.GA = (bf16*)args.out; F.GM = (bf16*)args.out + (size_t)MR * DM;
    for (int u = F.tid; u < (LDS_BYTES - LDSCTL_OFF) / 4; u += NWAVES * 64) ((LAS unsigned*)(F.lds + LDSCTL_OFF))[u] = 0u;
    __syncthreads();
    XcdBarrier bar; bar.bar = (unsigned*)(F.ctl + CW_BAR); bar.x = 0; bar.st = nullptr;
    if (N_LAUNCHES == 1) bar = xcd_barrier_post((unsigned*)(F.ctl + CW_BAR), F.MISC + 8);
#define GRID_BAR() do { if (N_LAUNCHES == 1) xcd_barrier(bar); } while (0)
    const int lo = args.ph_lo, hi = args.ph_hi;
#define IN(k) (lo <= (k) && (k) < hi)
#define BOTH(k) (IN(k) && IN((k) + 1))

    if (IN(0)) { p0_prologue(F); if (BOTH(0)) GRID_BAR(); }

    if (IN(1)) {
        pg8::Gemm g{F.U, F.W1T, MT, NIN, DM}; pg8::StaticOrder S; S.init(MT, NIN, F.G, (int)blockIdx.x);
        pg8::EpiInProj E{args.ws, (unsigned char*)args.out, F.ROPE};
        static_assert(WS_Q == 484 * MiB && WS_KV == 161 * MiB && WS_AZ == 612 * MiB && WS_MQK == 226 * MiB && WS_MV == 355 * MiB && WS_MO == 740 * MiB && WS_MZ == 868 * MiB, "EpiInProj offsets");
        pg8::gemm_phase<pg8::EpiInProj, pg8::StaticOrder, true, true>(F.lds + RING_OFF, g, S, E);
        if (BOTH(1)) GRID_BAR();
    }

    if (IN(2)) {
        conv_prepass(F);
        for (int u = blockIdx.x; u < BATCH * 32 * 4; u += F.G) attn_unit_simple(F, u);
        if (BOTH(2)) GRID_BAR();
    }
    if (IN(3)) {
        for (int c = blockIdx.x; c < BATCH * 16; c += F.G) ml::mlstm_chain(F, c);
        if (BOTH(3)) GRID_BAR();
    }

    if (IN(4)) { p3_min(F); if (BOTH(4)) GRID_BAR(); }

    if (IN(5)) {
        pg8::Gemm g{F.Q, F.WAO, MR, DM, DM}; pg8::StaticOrder S; S.init(MR, DM, F.G, (int)blockIdx.x);
        pg8::EpiGate E{F.GA, nullptr, F.AZ};
        pg8::gemm_phase<pg8::EpiGate, pg8::StaticOrder, true, true>(F.lds + RING_OFF, g, S, E);
        if (BOTH(5)) GRID_BAR();
    }
    if (IN(6)) {
        pg8::Gemm g{F.MV, F.WMO, MR, DM, DM}; pg8::StaticOrder S; S.init(MR, DM, F.G, (int)blockIdx.x);
        pg8::EpiGate E{F.GM, F.AZ, F.MQK};
        pg8::gemm_phase<pg8::EpiGate, pg8::StaticOrder, true, true>(F.lds + RING_OFF, g, S, E);
        if (BOTH(6)) GRID_BAR();
    }
    if (IN(7)) {
        pg8::Gemm g{F.MQK, F.WOUT, MR, DM, DM}; pg8::StaticOrder S; S.init(MR, DM, F.G, (int)blockIdx.x);
        pg8::EpiF32 E{F.OUTF, DM};
        pg8::gemm_phase<pg8::EpiF32, pg8::StaticOrder, true, true>(F.lds + RING_OFF, g, S, E);
        if (BOTH(7)) GRID_BAR();
    }
    if (IN(8)) { p7_final(F); }
#undef IN
#undef BOTH
}

extern "C" void kernel_launch(void* const* d_in, const int* in_sizes, int n_in, void* d_out, int out_size, void* d_ws, size_t ws_size, hipStream_t stream) {
    static int grid = 0;
    if (grid == 0) {
        if (n_in != 13 || in_sizes[0] != MR * DM || out_size != MR * DM || ws_size < WS_END) { fprintf(stderr, "kernel_launch: unexpected shapes (n_in %d, in0 %d, out %d, ws %zu); nothing launched\n", n_in, n_in > 0 ? in_sizes[0] : -1, out_size, ws_size); grid = -1; return; }
        int dev = 0, cus = 0, per_cu = 0;
        if (hipGetDevice(&dev) != hipSuccess || hipDeviceGetAttribute(&cus, hipDeviceAttributeMultiprocessorCount, dev) != hipSuccess) { grid = -1; return; }
        if (hipFuncSetAttribute((const void*)hyb_fwd, hipFuncAttributeMaxDynamicSharedMemorySize, LDS_BYTES) != hipSuccess) { fprintf(stderr, "kernel_launch: hipFuncSetAttribute failed\n"); grid = -1; return; }
        if (hipOccupancyMaxActiveBlocksPerMultiprocessor(&per_cu, (const void*)hyb_fwd, NWAVES * 64, LDS_BYTES) != hipSuccess || per_cu < 1)
            fprintf(stderr, "kernel_launch: note: occupancy query reports %d workgroups per CU\n", per_cu);
        (void)hipGetLastError();
        grid = cus;
    }
    if (grid < 0) return;
    if (hipMemsetAsync((char*)d_ws + WS_CTL, 0, CTL_ZERO_BYTES, stream) != hipSuccess) { fprintf(stderr, "kernel_launch: hipMemsetAsync failed\n"); return; }
    Args a{};
    for (int i = 0; i < 13; ++i) a.in[i] = (const float*)d_in[i];
    a.out = (float*)d_out; a.ws = (unsigned char*)d_ws;
    for (int li = 0; li < N_LAUNCHES; ++li) {
        a.ph_lo = (N_LAUNCHES == 1) ? 0 : li; a.ph_hi = (N_LAUNCHES == 1) ? PER_PHASE : li + 1; a.li = li;
        hipLaunchKernelGGL(hyb_fwd, dim3(grid), dim3(NWAVES * 64), LDS_BYTES, stream, a);
        const hipError_t le = hipPeekAtLastError();
        if (le != hipSuccess) { fprintf(stderr, "kernel_launch: launch %d failed: %s\n", li, hipGetErrorName(le)); break; }
    }
}
```

```cpp
#include <hip/hip_runtime.h>
#include <cstdio>
#include <cstdint>
#ifndef MK_ONE_LAUNCH
#define MK_ONE_LAUNCH 1
#endif
namespace pg8 {
#define PG8_LAS __attribute__((address_space(3)))
typedef unsigned short bf16_t;
typedef short bf16x8 __attribute__((ext_vector_type(8)));
typedef float f32x4 __attribute__((ext_vector_type(4)));
typedef unsigned u32x4 __attribute__((ext_vector_type(4)));
constexpr int BM = 256, BK = 64, HALF = 128, HTB = HALF * BK * 2  , STAGE_BYTES = 8 * HTB, NXCD = 8, WGM = 8;

__host__ __device__ __forceinline__ int lds_byte(int r, int c) { const int st = (r >> 4) * 2 + (c >> 5), rr = r & 15, cc = c & 31, ob = rr * 64 + cc * 2; return st * 1024 + (ob ^ (((ob >> 9) & 1) << 5)); }
__host__ __device__ __forceinline__ void stage_rc(int b, int& R, int& C) { const int st = b / 1024, sb = b % 1024, swz = sb ^ (((sb >> 9) & 1) << 5); R = (st >> 1) * 16 + swz / 64; C = (st & 1) * 32 + (swz % 64) / 2; }
__host__ __device__ __forceinline__ int perm32(int rho) { const int n = rho >> 4, i = rho & 15; return 8 * (i >> 2) + 4 * n + (i & 3); }

struct Unit { int pm, pn; };
struct Gemm { const bf16_t* A; const bf16_t* Bt; int M, N, K; };

struct StaticOrder {
    int nM, nN, nwg, G, c;
    __host__ __device__ void init(int M, int N, int G_, int c_) { nM = M / BM; nN = N / BM; nwg = nM * nN; G = G_; c = c_; }
    __host__ __device__ bool next(int i, Unit& u) const {
        const long L = (long)i * G + c; if (L >= nwg) return false;
        int wgid = (int)L; { const int q = nwg / NXCD, r = nwg % NXCD, xcd = wgid % NXCD, off = wgid / NXCD; wgid = (xcd < r ? xcd * (q + 1) : r * (q + 1) + (xcd - r) * q) + off; }
        const int nig = WGM * nN, gid = wgid / nig, fm = gid * WGM, gsz = (nM - fm) < WGM ? (nM - fm) : WGM;
        u.pm = fm + ((wgid % nig) % gsz); u.pn = (wgid % nig) / gsz; return true;
    }
    __device__ __forceinline__ void a_ready(const Unit&) const {}
    __device__ __forceinline__ void done(const Unit&) const {}
};

__device__ __forceinline__ unsigned cvt_pk_bf16(float lo, float hi) { unsigned r; asm volatile("v_cvt_pk_bf16_f32 %0, %1, %2" : "=v"(r) : "v"(lo), "v"(hi)); return r; }
__device__ __forceinline__ float bflo(unsigned w) { return __uint_as_float(w << 16); }
__device__ __forceinline__ float bfhi(unsigned w) { return __uint_as_float(w & 0xffff0000u); }
__device__ __forceinline__ float sigmoidf_(float x) { return 1.0f / (1.0f + __expf(-x)); }
__device__ __forceinline__ float siluf_(float x) { return x / (1.0f + __expf(-x)); }

constexpr int ROWS_REAL = 65536;

struct EpiInProj {
    static constexpr bool PERM = true, AFTER_DRAIN = false;
    unsigned char* ws; unsigned char* dout; const float* rope;
    __device__ __forceinline__ void operator()(const f32x4 (&acc)[2][2][4][2], const Unit& u, int wr, int wc, int fr, int fq) const {
        const int pn = u.pn; size_t boff; int ldc = 1024, colt, act; bool meta = false;
        constexpr size_t MB = 1u << 20;
        if (pn < 4)       { boff = 484 * MB; colt = pn * 256;        act = 4; }
        else if (pn == 4) { boff = 161 * MB; colt = 0;   ldc = 512;  act = 3; meta = true; }
        else if (pn == 5) { boff = 161 * MB; colt = 256; ldc = 512;  act = 0; meta = true; }
        else if (pn < 10) { boff = 612 * MB; colt = (pn - 6) * 256;  act = 1; }
        else if (pn < 14) { boff = 226 * MB; colt = (pn - 10) * 256; act = 0; meta = true; }
        else if (pn < 18) { boff = 355 * MB; colt = (pn - 14) * 256; act = 0; meta = true; }
        else if (pn < 22) { boff = 740 * MB; colt = (pn - 18) * 256; act = 2; }
        else if (pn < 26) { boff = 868 * MB; colt = (pn - 22) * 256; act = 1; }
        else if (pn < 30) { boff = 0;        colt = (pn - 26) * 256; act = 2; }
        else              { boff = 128 * MB; colt = (pn - 30) * 256; act = 2; }
        bf16_t* base = (bf16_t*)((pn >= 26 ? dout : ws) + boff);
        if (u.pm == 256 && !meta) return;
        const int row0 = u.pm * BM + wr * 64 + fr, col0 = colt + wc * 32 + 8 * fq;
        const bool ropel = ((wc & 1) == 0) && (fq < 2);
#pragma unroll
        for (int ai = 0; ai < 2; ++ai)
#pragma unroll
            for (int m = 0; m < 4; ++m) {
                const int row = row0 + ai * HALF + m * 16;
                bf16_t* rowp = base + (size_t)row * ldc + col0;
                f32x4 cs0, cs1, sn0, sn1;
                if (act >= 3) { const int pos = (u.pm == 256) ? (row - ROWS_REAL) : 16 + (row & 4095); const float* rp = rope + (size_t)pos * 16;
                    cs0 = *(const f32x4*)(rp); cs1 = *(const f32x4*)(rp + 4); sn0 = *(const f32x4*)(rp + 8); sn1 = *(const f32x4*)(rp + 12); }
#pragma unroll
                for (int bj = 0; bj < 2; ++bj) {
                    f32x4 v0 = acc[ai][bj][m][0], v1 = acc[ai][bj][m][1];
                    if (act == 1) {
#pragma unroll
                        for (int e = 0; e < 4; ++e) { v0[e] = siluf_(v0[e]); v1[e] = siluf_(v1[e]); }
                    } else if (act == 2) {
#pragma unroll
                        for (int e = 0; e < 4; ++e) { v0[e] = sigmoidf_(v0[e]); v1[e] = sigmoidf_(v1[e]); }
                    } else if (act >= 3) {
                        f32x4 p0, p1;
#pragma unroll
                        for (int e = 0; e < 4; ++e) { p0[e] = __shfl_xor(v0[e], 16); p1[e] = __shfl_xor(v1[e], 16); }
                        if (ropel) {
                            if (fq == 0) { v0 = v0 * cs0 - p0 * sn0; v1 = v1 * cs1 - p1 * sn1; }
                            else         { v0 = v0 * cs0 + p0 * sn0; v1 = v1 * cs1 + p1 * sn1; }
                        }
                        if (act == 4) { v0 = v0 * 0.18033688011112042f; v1 = v1 * 0.18033688011112042f; }
                    }
                    u32x4 w; w.x = cvt_pk_bf16(v0[0], v0[1]); w.y = cvt_pk_bf16(v0[2], v0[3]); w.z = cvt_pk_bf16(v1[0], v1[1]); w.w = cvt_pk_bf16(v1[2], v1[3]);
                    *(u32x4*)(rowp + bj * HALF) = w;
                }
            }
    }
};
struct EpiGate {
    static constexpr bool PERM = true, AFTER_DRAIN = false;
    const bf16_t* G; const bf16_t* T; bf16_t* O;
    __device__ __forceinline__ void operator()(const f32x4 (&acc)[2][2][4][2], const Unit& u, int wr, int wc, int fr, int fq) const {
        const int row0 = u.pm * BM + wr * 64 + fr, col0 = u.pn * BM + wc * 32 + 8 * fq;
#pragma unroll
        for (int ai = 0; ai < 2; ++ai)
#pragma unroll
            for (int m = 0; m < 4; ++m) { const size_t off = (size_t)(row0 + ai * HALF + m * 16) * 1024 + col0;
#pragma unroll
                for (int bj = 0; bj < 2; ++bj) {
                    const u32x4 g = *(const u32x4*)(G + off + bj * HALF);
                    f32x4 v0 = acc[ai][bj][m][0], v1 = acc[ai][bj][m][1];
                    v0[0] *= bflo(g.x); v0[1] *= bfhi(g.x); v0[2] *= bflo(g.y); v0[3] *= bfhi(g.y);
                    v1[0] *= bflo(g.z); v1[1] *= bfhi(g.z); v1[2] *= bflo(g.w); v1[3] *= bfhi(g.w);
                    if (T) { const u32x4 t = *(const u32x4*)(T + off + bj * HALF);
                        v0[0] += bflo(t.x); v0[1] += bfhi(t.x); v0[2] += bflo(t.y); v0[3] += bfhi(t.y);
                        v1[0] += bflo(t.z); v1[1] += bfhi(t.z); v1[2] += bflo(t.w); v1[3] += bfhi(t.w); }
                    u32x4 w; w.x = cvt_pk_bf16(v0[0], v0[1]); w.y = cvt_pk_bf16(v0[2], v0[3]); w.z = cvt_pk_bf16(v1[0], v1[1]); w.w = cvt_pk_bf16(v1[2], v1[3]);
                    *(u32x4*)(O + off + bj * HALF) = w; } }
    }
};
struct EpiF32 {
    static constexpr bool PERM = false, AFTER_DRAIN = false;
    float* C; int ldc;
    __device__ __forceinline__ void operator()(const f32x4 (&acc)[2][2][4][2], const Unit& u, int wr, int wc, int fr, int fq) const {
        const int row0 = u.pm * BM + wr * 64 + fr, col0 = u.pn * BM + wc * 32 + 4 * fq;
#pragma unroll
        for (int ai = 0; ai < 2; ++ai)
#pragma unroll
            for (int m = 0; m < 4; ++m) { float* rowp = C + (size_t)(row0 + ai * HALF + m * 16) * ldc + col0;
#pragma unroll
                for (int bj = 0; bj < 2; ++bj)
#pragma unroll
                    for (int n = 0; n < 2; ++n) *(f32x4*)(rowp + bj * HALF + n * 16) = acc[ai][bj][m][n]; }
    }
};

template <class Epi, class Sched, bool ALIGN_EPI = false, bool SP2 = false>
__device__ __forceinline__ void gemm_phase(PG8_LAS unsigned char* lds, const Gemm g, const Sched& S, const Epi& E) {
    const int tid = threadIdx.x, wid = __builtin_amdgcn_readfirstlane(tid >> 6), lane = tid & 63, wr = wid >> 2, wc = wid & 3, fr = lane & 15, fq = lane >> 4;
    const int K = g.K, nt = K / BK;
    unsigned voffA[2], voffB[2];
#pragma unroll
    for (int i = 0; i < 2; ++i) { int R, C; stage_rc(tid * 16 + i * 8192, R, C); const int Rb = Epi::PERM ? ((R & ~31) + perm32(R & 31)) : R;
        voffA[i] = (unsigned)(R * K + C) * 2u; voffB[i] = (unsigned)(Rb * K + C) * 2u; }
    const size_t kstep = (size_t)(BK * 2);
    const size_t hstep = (size_t)HALF * K * 2;
    const size_t tstep = 2 * hstep;
    const unsigned ldsw = (unsigned)wid * 1024u;
    const int aoff = lds_byte(wr * 64 + fr, fq * 8), boff = lds_byte(wc * 32 + fr, fq * 8);
#define PG8_SA(b, h) (((b) * 2 + (h)) * HTB)
#define PG8_SB(b, h) ((4 + (b) * 2 + (h)) * HTB)
#define PG8_STAGE(bufoff, gbase, voff) do { _Pragma("unroll") for (int _i = 0; _i < 2; ++_i) \
        __builtin_amdgcn_global_load_lds((const unsigned*)((const char*)(gbase) + (voff)[_i]), (PG8_LAS unsigned*)(lds + (bufoff) + ldsw + _i * 8192), 16, 0, 0); } while (0)
#define PG8_LDA(dst, b, h) do { _Pragma("unroll") for (int m = 0; m < 4; ++m) _Pragma("unroll") for (int k = 0; k < 2; ++k) dst[m][k] = *(const PG8_LAS bf16x8*)(lds + PG8_SA(b, h) + aoff + m * 2048 + k * 1024); } while (0)
#define PG8_LDB(dst, b, h) do { _Pragma("unroll") for (int n = 0; n < 2; ++n) _Pragma("unroll") for (int k = 0; k < 2; ++k) dst[n][k] = *(const PG8_LAS bf16x8*)(lds + PG8_SB(b, h) + boff + n * 2048 + k * 1024); } while (0)
#define PG8_MMA(ai, bj, At, Bt) do { __builtin_amdgcn_s_setprio(1); _Pragma("unroll") for (int m = 0; m < 4; ++m) _Pragma("unroll") for (int n = 0; n < 2; ++n) _Pragma("unroll") for (int k = 0; k < 2; ++k) \
        acc[ai][bj][m][n] = __builtin_amdgcn_mfma_f32_16x16x32_bf16(Bt[n][k], At[m][k], acc[ai][bj][m][n], 0, 0, 0); __builtin_amdgcn_s_setprio(0); } while (0)
#define PG8_WAIT_V(n) asm volatile("s_waitcnt vmcnt(" #n ")" ::: "memory")
#define PG8_WAIT_L(n) asm volatile("s_waitcnt lgkmcnt(" #n ")" ::: "memory")
#define PG8_BAR __builtin_amdgcn_s_barrier()
#define PG8_SCHED __builtin_amdgcn_sched_barrier(0)
    Unit cur, nxt; int ui = 0;
    if (!S.next(0, cur)) return;
    f32x4 acc[2][2][4][2];
#pragma unroll
    for (int a = 0; a < 2; ++a)
#pragma unroll
        for (int b = 0; b < 2; ++b)
#pragma unroll
            for (int m = 0; m < 4; ++m)
#pragma unroll
                for (int n = 0; n < 2; ++n) acc[a][b][m][n] = (f32x4){0.f, 0.f, 0.f, 0.f};
    bf16x8 At[4][2], B0[2][2], B1[2][2];
    const char* cA = (const char*)g.A + (size_t)cur.pm * tstep; const char* cB = (const char*)g.Bt + (size_t)cur.pn * tstep;
    S.a_ready(cur);
    if constexpr (SP2) {
        PG8_STAGE(PG8_SB(0, 0), cB, voffB); PG8_STAGE(PG8_SB(0, 1), cB + hstep, voffB); PG8_STAGE(PG8_SA(0, 0), cA, voffA); PG8_STAGE(PG8_SA(0, 1), cA + hstep, voffA);
        if (wr == 1) PG8_BAR;
        PG8_WAIT_V(2); PG8_BAR;
        PG8_STAGE(PG8_SB(1, 0), cB + kstep, voffB); PG8_STAGE(PG8_SA(1, 0), cA + kstep, voffA); PG8_STAGE(PG8_SB(1, 1), cB + hstep + kstep, voffB);
        PG8_WAIT_V(6); PG8_BAR;
    } else {
        PG8_STAGE(PG8_SB(0, 0), cB, voffB); PG8_STAGE(PG8_SA(0, 0), cA, voffA); PG8_STAGE(PG8_SB(0, 1), cB + hstep, voffB); PG8_STAGE(PG8_SA(0, 1), cA + hstep, voffA);
        if (wr == 1) PG8_BAR;
        PG8_WAIT_V(4); PG8_BAR;
        PG8_STAGE(PG8_SB(1, 0), cB + kstep, voffB); PG8_STAGE(PG8_SA(1, 0), cA + kstep, voffA); PG8_STAGE(PG8_SB(1, 1), cB + hstep + kstep, voffB);
        PG8_WAIT_V(6); PG8_BAR;
    }
    for (;;) {
        const bool has_next = S.next(ui + 1, nxt);
        const char* nA = has_next ? (const char*)g.A + (size_t)nxt.pm * tstep : cA; const char* nB = has_next ? (const char*)g.Bt + (size_t)nxt.pn * tstep : cB;
        for (int t = 0; t < nt; t += 2) {
            const bool last = (t == nt - 2);
            const char* a1 = cA + (size_t)(t + 1) * kstep;
            const char* a2 = last ? nA : cA + (size_t)(t + 2) * kstep; const char* b2 = last ? nB : cB + (size_t)(t + 2) * kstep;
            const char* a3 = a2 + kstep; const char* b3 = b2 + kstep;
            if (last && has_next) S.a_ready(nxt);
            if constexpr (SP2) {
            PG8_LDB(B0, 0, 0); PG8_LDB(B1, 0, 1); PG8_SCHED; PG8_LDA(At, 0, 0); PG8_STAGE(PG8_SA(1, 1), a1 + hstep, voffA);
            PG8_WAIT_V(8); PG8_WAIT_L(0); PG8_BAR; PG8_MMA(0, 0, At, B0); PG8_MMA(0, 1, At, B1); PG8_BAR; PG8_SCHED;
            PG8_LDA(At, 0, 1); PG8_STAGE(PG8_SB(0, 0), b2, voffB); PG8_STAGE(PG8_SB(0, 1), b2 + hstep, voffB); PG8_STAGE(PG8_SA(0, 0), a2, voffA);
            PG8_WAIT_V(8); PG8_WAIT_L(0); PG8_BAR; PG8_MMA(1, 0, At, B0); PG8_MMA(1, 1, At, B1); PG8_BAR; PG8_SCHED;
            PG8_LDB(B0, 1, 0); PG8_LDB(B1, 1, 1); PG8_SCHED; PG8_LDA(At, 1, 0); PG8_STAGE(PG8_SA(0, 1), a2 + hstep, voffA);
            PG8_WAIT_V(8); PG8_WAIT_L(0); PG8_BAR; PG8_MMA(0, 0, At, B0); PG8_MMA(0, 1, At, B1); PG8_BAR; PG8_SCHED;
            PG8_LDA(At, 1, 1); PG8_STAGE(PG8_SB(1, 0), b3, voffB); PG8_STAGE(PG8_SB(1, 1), b3 + hstep, voffB); PG8_STAGE(PG8_SA(1, 0), a3, voffA);
            PG8_WAIT_V(8); PG8_WAIT_L(0); PG8_BAR; PG8_MMA(1, 0, At, B0); PG8_MMA(1, 1, At, B1); PG8_BAR; PG8_SCHED;
            } else {
            PG8_LDB(B0, 0, 0); PG8_SCHED; PG8_LDA(At, 0, 0); PG8_STAGE(PG8_SA(1, 1), a1 + hstep, voffA);
            PG8_WAIT_L(8); PG8_BAR; PG8_WAIT_L(0); PG8_MMA(0, 0, At, B0); PG8_BAR; PG8_SCHED;
            PG8_LDB(B1, 0, 1); PG8_STAGE(PG8_SB(0, 0), b2, voffB);
            PG8_BAR; PG8_WAIT_L(0); PG8_MMA(0, 1, At, B1); PG8_BAR;
            PG8_LDA(At, 0, 1); PG8_STAGE(PG8_SA(0, 0), a2, voffA);
            PG8_BAR; PG8_WAIT_L(0); PG8_MMA(1, 0, At, B0); PG8_BAR; PG8_SCHED;
            PG8_STAGE(PG8_SB(0, 1), b2 + hstep, voffB);
            PG8_WAIT_V(6); PG8_BAR; PG8_MMA(1, 1, At, B1); PG8_BAR;
            PG8_LDB(B0, 1, 0); PG8_SCHED; PG8_LDA(At, 1, 0); PG8_STAGE(PG8_SA(0, 1), a2 + hstep, voffA);
            PG8_WAIT_L(8); PG8_BAR; PG8_WAIT_L(0); PG8_MMA(0, 0, At, B0); PG8_BAR; PG8_SCHED;
            PG8_LDB(B1, 1, 1); PG8_STAGE(PG8_SB(1, 0), b3, voffB);
            PG8_BAR; PG8_WAIT_L(0); PG8_MMA(0, 1, At, B1); PG8_BAR;
            PG8_LDA(At, 1, 1); PG8_STAGE(PG8_SA(1, 0), a3, voffA);
            PG8_BAR; PG8_WAIT_L(0); PG8_MMA(1, 0, At, B0); PG8_BAR; PG8_SCHED;
            PG8_STAGE(PG8_SB(1, 1), b3 + hstep, voffB);
            PG8_WAIT_V(6); PG8_BAR; PG8_MMA(1, 1, At, B1); PG8_BAR;
            }
        }
        if constexpr (ALIGN_EPI) { if (wr == 0) PG8_BAR; }
        if constexpr (!Epi::AFTER_DRAIN) { E(acc, cur, wr, wc, fr, fq); S.done(cur); }
        if (!has_next) break;
#pragma unroll
        for (int a = 0; a < 2; ++a)
#pragma unroll
            for (int b = 0; b < 2; ++b)
#pragma unroll
                for (int m = 0; m < 4; ++m)
#pragma unroll
                    for (int n = 0; n < 2; ++n) acc[a][b][m][n] = (f32x4){0.f, 0.f, 0.f, 0.f};
        cur = nxt; cA = nA; cB = nB; ++ui;
        if constexpr (ALIGN_EPI) { if (wr == 1) PG8_BAR; }
    }
    PG8_WAIT_V(0);
    if constexpr (!ALIGN_EPI) { if (wr == 0) PG8_BAR; }
    PG8_BAR;
    if constexpr (Epi::AFTER_DRAIN) { E.fused(acc, cur, wr, wc, fr, fq, lds, wid, lane); S.done(cur); }
#undef PG8_SA
#undef PG8_SB
#undef PG8_STAGE
#undef PG8_LDA
#undef PG8_LDB
#undef PG8_MMA
#undef PG8_WAIT_V
#undef PG8_WAIT_L
#undef PG8_BAR
#undef PG8_SCHED
}
}

constexpr int NWAVES = 8;
constexpr int BATCH = 16, SEQ = 4096, DM = 1024, NMETA = 16;
constexpr int MR = BATCH * SEQ;
constexpr int MT = MR + 256;
constexpr int IN_W = 8712, NIN = 8704;
constexpr int GATE_COL = 4608;
constexpr float RMS_EPS = 1e-6f, LN_EPS = 1e-6f;
constexpr int PER_PHASE = 9;
constexpr int N_LAUNCHES = MK_ONE_LAUNCH ? 1 : PER_PHASE;

constexpr size_t MiB = 1u << 20;
constexpr size_t WS_CTL = 0, CTL_ZERO_BYTES = 1 * MiB;
constexpr size_t WS_W1T = 2 * MiB, WS_WAO = 19 * MiB, WS_WMO = 21 * MiB, WS_WOUT = 23 * MiB;
constexpr size_t WS_ROPE = 25 * MiB;
constexpr size_t WS_IF = 26 * MiB;
constexpr size_t WS_U = 32 * MiB;
constexpr size_t WS_KV = 161 * MiB;
constexpr size_t WS_MQK = 226 * MiB;
constexpr size_t WS_MV = 355 * MiB;
constexpr size_t WS_Q = 484 * MiB;
constexpr size_t WS_AZ = 612 * MiB;
constexpr size_t WS_MO = 740 * MiB;
constexpr size_t WS_MZ = 868 * MiB;
constexpr size_t WS_OUTF = WS_MO;
constexpr size_t WS_END = 996 * MiB;
constexpr int CW_TMO = 0, CW_CODE = 1;
constexpr int CW_BAR = 4096;

constexpr int RING_OFF = 0, RING_BYTES = 135168;
constexpr int LDSCTL_OFF = RING_BYTES, MISC_OFF = LDSCTL_OFF + 320;
constexpr int LDS_BYTES = 147456;
static_assert(MISC_OFF + 128 <= LDS_BYTES, "LDS map");

#define GAS __attribute__((address_space(1)))
#define LAS __attribute__((address_space(3)))
typedef unsigned short bf16;
typedef unsigned v4u __attribute__((ext_vector_type(4)));
typedef float f32x4 __attribute__((ext_vector_type(4)));
typedef short bf16x8 __attribute__((ext_vector_type(8)));
typedef GAS unsigned gu32;
typedef GAS unsigned long long gu64;
#define RLX_AGENT __ATOMIC_RELAXED, __HIP_MEMORY_SCOPE_AGENT
#define LDS_WAIT() asm volatile("s_waitcnt lgkmcnt(0)" ::: "memory")
#define VM_WAIT() asm volatile("s_waitcnt vmcnt(0)" ::: "memory")
__device__ __forceinline__ unsigned long long rt() { return __builtin_amdgcn_s_memrealtime(); }
__device__ __forceinline__ unsigned f2bf(float f) { unsigned u = __builtin_bit_cast(unsigned, f); return (u + 0x7fffu + ((u >> 16) & 1u)) >> 16; }
__device__ __forceinline__ unsigned pk2(float lo, float hi) { return f2bf(lo) | (f2bf(hi) << 16); }

#define XB_TMO      128
#define XB_XCNT(j)  (256  + 64 * (j))
#define XB_XSUB(j)  (1280 + 64 * (j))
#define XB_XGEN(j)  (2304 + 64 * (j))
#define XB_TOP      3328
#define XB_TOPGEN   3392
#define XCD_BAR_WORDS 3456
#define XB_SPIN_CAP (1u << 18)

__device__ __forceinline__ unsigned xb_ld(unsigned* p)              { return __hip_atomic_load(p, __ATOMIC_RELAXED, __HIP_MEMORY_SCOPE_AGENT); }
__device__ __forceinline__ unsigned xb_add(unsigned* p, unsigned v) { return __hip_atomic_fetch_add(p, v, __ATOMIC_RELAXED, __HIP_MEMORY_SCOPE_AGENT); }
__device__ __forceinline__ unsigned xb_xcc_id() { return (unsigned)__builtin_amdgcn_s_getreg((3 << 11) | 20) & 0xFu; }
#define XB_SPIN(cond, bar) do { unsigned _sp = 0; while (cond) { __builtin_amdgcn_s_sleep(1); \
    if ((++_sp & 255u) == 0u) { if (xb_ld(&(bar)[XB_TMO])) break; if (_sp > XB_SPIN_CAP) { atomicAdd(&(bar)[XB_TMO], 1u); break; } } } } while (0)

struct XcdBarrier {
    unsigned* bar; unsigned x;
    volatile LAS unsigned* st;
};

__device__ __forceinline__ XcdBarrier xcd_barrier_post(unsigned* bar, volatile LAS unsigned* st) {
    XcdBarrier b; b.bar = bar; b.x = xb_xcc_id(); b.st = st;
    if (threadIdx.x == 0) (void)xb_add(&bar[XB_XCNT(b.x)], 1u);
    return b;
}
__device__ __forceinline__ void xcd_barrier_complete(unsigned* bar, unsigned x, unsigned& nloc, unsigned& nx) {
    const unsigned G = gridDim.x * gridDim.y * gridDim.z;
    unsigned sum, cnt, mine, sp = 0u;
    for (;;) {
        sum = 0u; cnt = 0u; mine = 0u;
#pragma unroll
        for (unsigned j = 0; j < 16; ++j) { const unsigned c = xb_ld(&bar[XB_XCNT(j)]); sum += c; cnt += (c > 0u) ? 1u : 0u; mine = (j == x) ? c : mine; }
        if (sum == G) break;
        __builtin_amdgcn_s_sleep(1);
        if ((++sp & 255u) == 0u) { if (xb_ld(&bar[XB_TMO])) break; if (sp > XB_SPIN_CAP) { atomicAdd(&bar[XB_TMO], 1u); break; } }
    }
    nloc = mine > 0u ? mine : 1u; nx = cnt > 0u ? cnt : 1u;
}

__device__ __forceinline__ void xcd_barrier(const XcdBarrier& b) {
    asm volatile("s_waitcnt vmcnt(0)" ::: "memory");
    __syncthreads();
    if (threadIdx.x == 0) {
        unsigned* bar = b.bar;
        __builtin_amdgcn_s_waitcnt(0);
        unsigned nloc = b.st[0], nx = b.st[1];
        if (nloc == 0u) { xcd_barrier_complete(bar, b.x, nloc, nx); b.st[0] = nloc; b.st[1] = nx; }
        const unsigned old = xb_add(&bar[XB_XSUB(b.x)], 1u);
        const unsigned gen = old / nloc;
        if (old + 1u == (gen + 1u) * nloc) {
            __builtin_amdgcn_fence(__ATOMIC_RELEASE, "agent");
            asm volatile("s_waitcnt vmcnt(0)" ::: "memory");
            const unsigned og = xb_add(&bar[XB_TOP], 1u);
            const unsigned tg = og / nx;
            if (og + 1u == (tg + 1u) * nx) xb_add(&bar[XB_TOPGEN], 1u);
            else XB_SPIN(xb_ld(&bar[XB_TOPGEN]) == tg, bar);
            __builtin_amdgcn_fence(__ATOMIC_ACQUIRE, "agent");
            xb_add(&bar[XB_XGEN(b.x)], 1u);
            asm volatile("s_waitcnt vmcnt(0)" ::: "memory");
        } else {
            XB_SPIN(xb_ld(&bar[XB_XGEN(b.x)]) == gen, bar);
            __builtin_amdgcn_fence(__ATOMIC_ACQUIRE, "agent");
            asm volatile("s_waitcnt vmcnt(0)" ::: "memory");
        }
    }
    __syncthreads();
}

struct Frame {
    LAS unsigned char* lds;
    volatile LAS unsigned* MISC;
    gu32* ctl;
    int tid, lane, wave;
    int vcu, G;
    const float *x, *meta, *norm_pre, *w_in, *sinks, *conv_w, *conv_b, *gate_bias, *head_norm, *w_ao, *w_mo, *w_out, *norm_post;
    float* out;
    bf16 *W1T, *WAO, *WMO, *WOUT;
    float *ROPE, *IF, *OUTF;
    bf16 *U, *KV, *MQK, *MV, *Q, *AZ, *MO, *MZ, *GA, *GM;
};
__device__ __forceinline__ float wave_sum(float v) {
#pragma unroll
    for (int o = 1; o < 64; o <<= 1) v += __shfl_xor(v, o);
    return v;
}
__device__ __forceinline__ float wave_max(float v) {
#pragma unroll
    for (int o = 1; o < 64; o <<= 1) v = fmaxf(v, __shfl_xor(v, o));
    return v;
}
__device__ __forceinline__ float bf2f(bf16 v) { return __uint_as_float((unsigned)v << 16); }
__device__ __forceinline__ float bflo(unsigned w) { return __uint_as_float(w << 16); }
__device__ __forceinline__ float bfhi(unsigned w) { return __uint_as_float(w & 0xffff0000u); }

__device__ __forceinline__ void p0_transpose_item(const float* W, int ldw, int K, bf16* WT, LAS float* scr, int nblk, int item, int lane, bool skipgate) {
    const int kb = item / nblk, nb = item % nblk, k0 = 64 * kb, n0 = 32 * nb;
    const int shift = (skipgate && n0 >= GATE_COL) ? 8 : 0;
#pragma unroll 8
    for (int i = 0; i < 32; ++i) { const int kk = 2 * i + (lane >> 5); scr[kk * 33 + (lane & 31)] = W[(size_t)(k0 + kk) * ldw + n0 + shift + (lane & 31)]; }
    LDS_WAIT(); asm volatile("" ::: "memory");
    const int c = lane & 7;
#pragma unroll
    for (int j = 0; j < 4; ++j) { const int n = (lane >> 3) + 8 * j; const LAS float* s = scr + (8 * c) * 33 + n;
        v4u o; o.x = pk2(s[0 * 33], s[1 * 33]); o.y = pk2(s[2 * 33], s[3 * 33]); o.z = pk2(s[4 * 33], s[5 * 33]); o.w = pk2(s[6 * 33], s[7 * 33]);
        *(GAS v4u*)(WT + (size_t)(n0 + n) * K + k0 + 8 * c) = o; }
    LDS_WAIT(); asm volatile("" ::: "memory");
}
__device__ __forceinline__ void p0_prologue(Frame& F) {
    LAS float* scr = (LAS float*)(F.lds + RING_OFF + F.wave * 16384);
    const int gw = F.vcu * NWAVES + F.wave, NGW = F.G * NWAVES, lane = F.lane;
    constexpr int I_IN = (DM / 64) * (NIN / 32), I_SQ = (DM / 64) * (DM / 32);
    constexpr int NITEMS = I_IN + 3 * I_SQ;
    for (int it = gw; it < NITEMS; it += NGW) {
        int r = it;
        if (r < I_IN) { p0_transpose_item(F.w_in, IN_W, DM, F.W1T, scr, NIN / 32, r, lane, true); continue; } r -= I_IN;
        if (r < I_SQ) { p0_transpose_item(F.w_ao, DM, DM, F.WAO, scr, DM / 32, r, lane, false); continue; } r -= I_SQ;
        if (r < I_SQ) { p0_transpose_item(F.w_mo, DM, DM, F.WMO, scr, DM / 32, r, lane, false); continue; } r -= I_SQ;
        p0_transpose_item(F.w_out, DM, DM, F.WOUT, scr, DM / 32, r, lane, false);
    }
    {
        const int gt = F.vcu * (NWAVES * 64) + F.tid, NGT = F.G * NWAVES * 64;
        for (int idx = gt; idx < (SEQ + NMETA) * 8; idx += NGT) {
            const int pos = idx >> 3, i = idx & 7;
            const float invf = (i == 0) ? 1.0f : (i == 1) ? 0.1939227432012558f : (i == 2) ? 0.03760603070259094f : (i == 3) ? 0.007292664609849453f :
                               (i == 4) ? 0.0014142135623842478f : (i == 5) ? 0.00027424818836152554f : (i == 6) ? 5.318296098266728e-05f : 1.0313386155758053e-05f;
            const float ang = (float)pos * invf;
            double rev = (double)ang * 0.15915494309189535; rev -= floor(rev);
            const float rf = (float)rev;
            F.ROPE[(size_t)pos * 16 + i] = __builtin_amdgcn_cosf(rf);
            F.ROPE[(size_t)pos * 16 + 8 + i] = __builtin_amdgcn_sinf(rf);
        }
    }
    {
        f32x4 wg[4][4][2];
#pragma unroll
        for (int j = 0; j < 4; ++j)
#pragma unroll
            for (int i = 0; i < 4; ++i) { const float* p = F.w_in + (size_t)(256 * j + 4 * lane + i) * IN_W + GATE_COL; wg[j][i][0] = *(const f32x4*)p; wg[j][i][1] = *(const f32x4*)(p + 4); }
        f32x4 gp[4];
#pragma unroll
        for (int j = 0; j < 4; ++j) gp[j] = *(const f32x4*)(F.norm_pre + 256 * j + 4 * lane);
        for (int m = gw; m < MT; m += NGW) {
            GAS unsigned long long* o8 = (GAS unsigned long long*)(F.U + (size_t)m * DM) + lane;
            if (m >= MR + NMETA) {
#pragma unroll
                for (int j = 0; j < 4; ++j) o8[64 * j] = 0ull;
                continue;
            }
            const float* xrow = (m < MR) ? F.x + (size_t)m * DM : F.meta + (size_t)(m - MR) * DM;
            const GAS f32x4* xr = (const GAS f32x4*)xrow + lane;
            f32x4 v[4]; float s = 0.f;
#pragma unroll
            for (int j = 0; j < 4; ++j) { v[j] = xr[64 * j]; s += (v[j].x * v[j].x + v[j].y * v[j].y) + (v[j].z * v[j].z + v[j].w * v[j].w); }
            const float rstd = 1.0f / sqrtf(wave_sum(s) * (1.f / DM) + RMS_EPS);
            f32x4 ga = {0.f, 0.f, 0.f, 0.f}, gb = {0.f, 0.f, 0.f, 0.f};
#pragma unroll
            for (int j = 0; j < 4; ++j) {
                v[j] = v[j] * rstd * gp[j];
                o8[64 * j] = (unsigned long long)pk2(v[j].x, v[j].y) | ((unsigned long long)pk2(v[j].z, v[j].w) << 32);
#pragma unroll
                for (int i = 0; i < 4; ++i) { ga += wg[j][i][0] * v[j][i]; gb += wg[j][i][1] * v[j][i]; }
            }
            float g8[8];
#pragma unroll
            for (int c = 0; c < 4; ++c) { g8[c] = wave_sum(ga[c]); g8[4 + c] = wave_sum(gb[c]); }
            if (lane < 8) {
                float val = 0.f;
#pragma unroll
                for (int c = 0; c < 8; ++c) val = (lane == c) ? g8[c] : val;
                val += F.gate_bias[lane];
                if (lane >= 4) { val = fminf(val, 0.f) - log1pf(__expf(-fabsf(val))); }
                F.IF[(size_t)m * 8 + lane] = val;
            }
        }
    }
}

__device__ __forceinline__ long seqrow(int b, int p) { return p < NMETA ? (long)MR + p : (long)b * SEQ + (p - NMETA); }
typedef unsigned u32x4_t __attribute__((ext_vector_type(4)));
__device__ __forceinline__ void conv_prepass(Frame& F) {
    const int gt = F.vcu * (NWAVES * 64) + F.tid, ch = gt & 127, c0 = 8 * ch;
    float w[4][8], bias[8];
#pragma unroll
    for (int e = 0; e < 8; ++e) { bias[e] = F.conv_b[c0 + e];
#pragma unroll
        for (int j = 0; j < 4; ++j) w[j][e] = F.conv_w[j * 1024 + c0 + e]; }
    const float osc = (ch >= 64) ? 0.08838834764831845f : 1.0f;
    const int rstep = (F.G * NWAVES * 64) >> 7;
    for (int r = gt >> 7; r < MR + NMETA; r += rstep) {
        float a[8];
#pragma unroll
        for (int e = 0; e < 8; ++e) a[e] = bias[e];
        const int s = r & 4095;
#pragma unroll
        for (int j = 0; j < 4; ++j) {
            long row;
            if (r < MR) { const int ss = s - 3 + j; row = (ss >= 0) ? (long)(r - 3 + j) : (long)MR + 16 + ss; }
            else { const int pp = (r - MR) - 3 + j; row = (pp >= 0) ? (long)MR + pp : -1; }
            if (row >= 0) { const v4u x = *(const GAS v4u*)(F.MQK + (size_t)row * DM + c0);
                a[0] += w[j][0] * bflo(x.x); a[1] += w[j][1] * bfhi(x.x); a[2] += w[j][2] * bflo(x.y); a[3] += w[j][3] * bfhi(x.y);
                a[4] += w[j][4] * bflo(x.z); a[5] += w[j][5] * bfhi(x.z); a[6] += w[j][6] * bflo(x.w); a[7] += w[j][7] * bfhi(x.w); }
        }
#pragma unroll
        for (int e = 0; e < 8; ++e) a[e] = a[e] / (1.0f + __expf(-a[e])) * osc;
        v4u o; o.x = pk2(a[0], a[1]); o.y = pk2(a[2], a[3]); o.z = pk2(a[4], a[5]); o.w = pk2(a[6], a[7]);
        *(GAS v4u*)(F.U + (size_t)r * DM + c0) = o;
    }
}

namespace ml {
using bf16x8 = __attribute__((ext_vector_type(8))) short;
using s16x4 = __attribute__((ext_vector_type(4))) short;
using f32x16 = __attribute__((ext_vector_type(16))) float;
typedef short v4i16_t __attribute__((ext_vector_type(4)));
typedef float f32x2_t __attribute__((ext_vector_type(2))); typedef __bf16 bf16x2_t __attribute__((ext_vector_type(2)));
__device__ __forceinline__ unsigned cvtpk(float lo, float hi) { f32x2_t v = {lo, hi}; bf16x2_t b = __builtin_convertvector(v, bf16x2_t); return __builtin_bit_cast(unsigned, b); }
__device__ __forceinline__ s16x4 trr(const LAS unsigned char* p) { return __builtin_bit_cast(s16x4, __builtin_amdgcn_ds_read_tr16_b64_v4i16((LAS v4i16_t*)p)); }
__device__ __forceinline__ bf16x8 cat8(s16x4 a, s16x4 b) { return (bf16x8){a[0], a[1], a[2], a[3], b[0], b[1], b[2], b[3]}; }
__device__ __forceinline__ int crow(int r, int hi) { return (r & 3) + 8 * (r >> 2) + 4 * hi; }
constexpr int QSTR = 272, VSTR = 192;
constexpr int L_QS = 0, L_KS = L_QS + 64 * QSTR, L_VS = L_KS + 64 * QSTR, L_WVS = L_VS + 64 * VSTR, L_XT = L_WVS + 64 * VSTR, L_G = L_XT + 64 * QSTR;
constexpr int G_CS = 0, G_RT = 64, G_WI = 128, G_EI = 192, G_WA = 256, G_WC = 320, G_SZ = 324;
constexpr int L_N = L_G + 2 * G_SZ * 4, L_SCR = L_N + 2 * 128 * 4, L_END = L_SCR + 4 * 32 * 4;
static_assert(L_END <= RING_BYTES, "mLSTM LDS map");

__device__ __forceinline__ void sc_tile(f32x16& st, const LAS float* cs, float rtv, int r32, int hi, bool diag, float& rs) {
#pragma unroll
    for (int g = 0; g < 4; ++g) { const f32x4 c4 = *(const LAS f32x4*)(cs + 8 * g + 4 * hi);
#pragma unroll
        for (int e = 0; e < 4; ++e) { const int reg = 4 * g + e; float v = st[reg] * __expf(c4[e] + rtv);
            if (diag && (8 * g + 4 * hi + e) > r32) v = 0.f;
            st[reg] = v; rs += v; } }
}

__device__ __forceinline__ void mlstm_chain(Frame& F, int chain) {
    const int b = chain >> 4, h = (chain >> 2) & 3, vsl = chain & 3;
    const int tid = F.tid, lane = F.lane, wid = F.wave, r32 = lane & 31, hi = lane >> 5, g4 = lane >> 4, i16 = lane & 15;
    LAS unsigned char* L = F.lds + RING_OFF;
    LAS float* GB = (LAS float*)(L + L_G);
    LAS float* NB = (LAS float*)(L + L_N);
    LAS float* SCR = (LAS float*)(L + L_SCR);
    const bf16* QKc = F.U;
    v4u pq[2], pk[2], pv;
    float m_carry = 0.f;
#define ML_PREFETCH(cn) do { \
        _Pragma("unroll") for (int i_ = 0; i_ < 2; ++i_) { const int idx_ = tid + 512 * i_, t_ = idx_ >> 4, pc_ = idx_ & 15, p_ = 64 * (cn) - 48 + t_; \
            if (p_ >= 0) { const size_t ro_ = (size_t)seqrow(b, p_) * DM + h * 128 + 8 * pc_; pq[i_] = *(const GAS v4u*)(QKc + ro_); pk[i_] = *(const GAS v4u*)(QKc + ro_ + 512); } \
            else { pq[i_] = (v4u){0u, 0u, 0u, 0u}; pk[i_] = (v4u){0u, 0u, 0u, 0u}; } } \
        { const int t_ = tid >> 3, pc_ = tid & 7, p_ = 64 * (cn) - 48 + t_; \
            if (p_ >= 0) pv = *(const GAS v4u*)(F.MV + (size_t)seqrow(b, p_) * DM + h * 256 + vsl * 64 + 8 * pc_); else pv = (v4u){0u, 0u, 0u, 0u}; } } while (0)
#define ML_STAGE(gb) do { \
        _Pragma("unroll") for (int i_ = 0; i_ < 2; ++i_) { const int idx_ = tid + 512 * i_, t_ = idx_ >> 4, pc_ = idx_ & 15; \
            *(LAS v4u*)(L + L_QS + t_ * QSTR + pc_ * 16) = pq[i_]; *(LAS v4u*)(L + L_KS + t_ * QSTR + pc_ * 16) = pk[i_]; } \
        { const int t_ = tid >> 3, pc_ = tid & 7; const float wa_ = (gb)[G_WA + t_]; \
            *(LAS v4u*)(L + L_VS + t_ * VSTR + pc_ * 16) = pv; v4u s_; \
            s_.x = cvtpk(bflo(pv.x) * wa_, bfhi(pv.x) * wa_); s_.y = cvtpk(bflo(pv.y) * wa_, bfhi(pv.y) * wa_); \
            s_.z = cvtpk(bflo(pv.z) * wa_, bfhi(pv.z) * wa_); s_.w = cvtpk(bflo(pv.w) * wa_, bfhi(pv.w) * wa_); \
            *(LAS v4u*)(L + L_WVS + t_ * VSTR + pc_ * 16) = s_; } } while (0)
#define ML_GATES(cn, gb) do { const int p_ = 64 * (cn) - 48 + lane; float li_ = -1e30f, lf_ = 0.f; \
        if (p_ >= 0) { const float* ip_ = F.IF + (size_t)seqrow(b, p_) * 8; li_ = ip_[h]; lf_ = ip_[4 + h]; } \
        float bc_ = lf_; \
        _Pragma("unroll") for (int o_ = 1; o_ < 64; o_ <<= 1) { const float u_ = __shfl_up(bc_, o_); if (lane >= o_) bc_ += u_; } \
        const float cv_ = li_ - bc_; float pm_ = cv_; \
        _Pragma("unroll") for (int o_ = 1; o_ < 64; o_ <<= 1) { const float u_ = __shfl_up(pm_, o_); if (lane >= o_) pm_ = fmaxf(pm_, u_); } \
        const float bl_ = __shfl(bc_, 63), pmx_ = __shfl(pm_, 63); \
        const float mnew_ = fmaxf(bl_ + m_carry, bl_ + pmx_); \
        const float rt_ = -fmaxf(m_carry, pm_); \
        (gb)[G_CS + lane] = cv_; (gb)[G_RT + lane] = rt_; (gb)[G_WI + lane] = __expf(m_carry + rt_); (gb)[G_EI + lane] = __expf(rt_ - bc_); \
        (gb)[G_WA + lane] = __expf(bl_ + cv_ - mnew_); if (lane == 0) (gb)[G_WC] = __expf(bl_ + m_carry - mnew_); \
        m_carry = mnew_; } while (0)

    f32x16 ax0, ax1;
#pragma unroll
    for (int r = 0; r < 16; ++r) { ax0[r] = 0.f; ax1[r] = 0.f; }
    __syncthreads();
    for (int i = tid; i < 64 * QSTR / 16; i += NWAVES * 64) *(LAS v4u*)(L + L_XT + i * 16) = (v4u){0u, 0u, 0u, 0u};
    if (tid < 128) NB[tid] = 0.f;
    if (wid == 6) ML_GATES(0, GB);
    ML_PREFETCH(0);
    __syncthreads();
    ML_STAGE(GB);
    __syncthreads();
    for (int c = 0; c < 65; ++c) {
        LAS float* gcur = GB + (c & 1) * G_SZ; LAS float* gnxt = GB + ((c & 1) ^ 1) * G_SZ;
        LAS float* ncur = NB + (c & 1) * 128;  LAS float* nnxt = NB + ((c & 1) ^ 1) * 128;
        if (c < 64) ML_PREFETCH(c + 1);
        if (wid < 4) {
            const int tb = wid >> 1, vb = wid & 1;
            bf16x8 qf[8];
            { const LAS unsigned char* qrow = L + L_QS + (32 * tb + r32) * QSTR + hi * 16;
#pragma unroll
              for (int kk = 0; kk < 8; ++kk) qf[kk] = *(const LAS bf16x8*)(qrow + kk * 32); }
            f32x16 acc, st0, st1;
#pragma unroll
            for (int r = 0; r < 16; ++r) { acc[r] = 0.f; st0[r] = 0.f; st1[r] = 0.f; }
            { const LAS unsigned char* xrow = L + L_XT + (32 * vb + r32) * QSTR + hi * 16;
#pragma unroll
              for (int kk = 0; kk < 8; ++kk) acc = __builtin_amdgcn_mfma_f32_32x32x16_bf16(qf[kk], *(const LAS bf16x8*)(xrow + kk * 32), acc, 0, 0, 0); }
            { const LAS unsigned char* krow = L + L_KS + r32 * QSTR + hi * 16;
#pragma unroll
              for (int kk = 0; kk < 8; ++kk) st0 = __builtin_amdgcn_mfma_f32_32x32x16_bf16(*(const LAS bf16x8*)(krow + kk * 32), qf[kk], st0, 0, 0, 0);
              if (tb == 1) {
#pragma unroll
                  for (int kk = 0; kk < 8; ++kk) st1 = __builtin_amdgcn_mfma_f32_32x32x16_bf16(*(const LAS bf16x8*)(krow + 32 * QSTR + kk * 32), qf[kk], st1, 0, 0, 0); } }
            const int t = 32 * tb + r32;
            const float rtv = gcur[G_RT + t];
            float rs = 0.f;
            if (tb == 0) sc_tile(st0, gcur + G_CS, rtv, r32, hi, true, rs);
            else { sc_tile(st0, gcur + G_CS, rtv, r32, hi, false, rs); sc_tile(st1, gcur + G_CS + 32, rtv, r32, hi, true, rs); }
            rs += __shfl_xor(rs, 32);
            float qn = 0.f;
#pragma unroll
            for (int kk = 0; kk < 8; ++kk) { const f32x4 n0 = *(const LAS f32x4*)(ncur + 16 * kk + 8 * hi), n1 = *(const LAS f32x4*)(ncur + 16 * kk + 8 * hi + 4);
#pragma unroll
                for (int j = 0; j < 4; ++j) { qn += __uint_as_float((unsigned)(unsigned short)qf[kk][j] << 16) * n0[j]; qn += __uint_as_float((unsigned)(unsigned short)qf[kk][4 + j] << 16) * n1[j]; } }
            qn += __shfl_xor(qn, 32);
            const float den = fmaxf(fabsf(gcur[G_WI + t] * qn + rs), gcur[G_EI + t]);
            SCR[wid * 32 + r32] = 1.0f / den;
            f32x4 wi4[4], rd4[4];
#pragma unroll
            for (int g = 0; g < 4; ++g) { wi4[g] = *(const LAS f32x4*)(gcur + G_WI + 32 * tb + 8 * g + 4 * hi); rd4[g] = *(const LAS f32x4*)(SCR + wid * 32 + 8 * g + 4 * hi); }
#pragma unroll
            for (int r = 0; r < 16; ++r) acc[r] *= wi4[r >> 2][r & 3];
            {
                const LAS unsigned char* vb0 = L + L_VS + (4 * hi + (i16 >> 2)) * VSTR + (32 * vb + 16 * (g4 & 1) + 4 * (i16 & 3)) * 2;
#pragma unroll
                for (int ks = 0; ks < 2; ++ks) {
                    u32x4_t a; a.x = cvtpk(st0[8 * ks + 0], st0[8 * ks + 1]); a.y = cvtpk(st0[8 * ks + 2], st0[8 * ks + 3]); a.z = cvtpk(st0[8 * ks + 4], st0[8 * ks + 5]); a.w = cvtpk(st0[8 * ks + 6], st0[8 * ks + 7]);
                    const bf16x8 bv = cat8(trr(vb0 + (16 * ks) * VSTR), trr(vb0 + (16 * ks + 8) * VSTR));
                    acc = __builtin_amdgcn_mfma_f32_32x32x16_bf16(__builtin_bit_cast(bf16x8, a), bv, acc, 0, 0, 0);
                }
                if (tb == 1) {
#pragma unroll
                    for (int ks = 0; ks < 2; ++ks) {
                        u32x4_t a; a.x = cvtpk(st1[8 * ks + 0], st1[8 * ks + 1]); a.y = cvtpk(st1[8 * ks + 2], st1[8 * ks + 3]); a.z = cvtpk(st1[8 * ks + 4], st1[8 * ks + 5]); a.w = cvtpk(st1[8 * ks + 6], st1[8 * ks + 7]);
                        const bf16x8 bv = cat8(trr(vb0 + (32 + 16 * ks) * VSTR), trr(vb0 + (32 + 16 * ks + 8) * VSTR));
                        acc = __builtin_amdgcn_mfma_f32_32x32x16_bf16(__builtin_bit_cast(bf16x8, a), bv, acc, 0, 0, 0);
                    }
                }
            }
            if (c >= 1) {
                bf16* op = F.MV + ((size_t)b * SEQ + (size_t)(c - 1) * 64 + 32 * tb) * DM + h * 256 + vsl * 64 + 32 * vb + r32;
#pragma unroll
                for (int r = 0; r < 16; ++r) op[(size_t)crow(r, hi) * DM] = (bf16)f2bf(acc[r] * rd4[r >> 2][r & 3]);
            }
        } else {
            const int db = wid - 4;
            const float wc_ = gcur[G_WC];
#pragma unroll
            for (int r = 0; r < 16; ++r) { ax0[r] *= wc_; ax1[r] *= wc_; }
            const LAS unsigned char* ka = L + L_KS + (8 * hi + (i16 >> 2)) * QSTR + (32 * db + 16 * (g4 & 1) + 4 * (i16 & 3)) * 2;
            const LAS unsigned char* va = L + L_WVS + (8 * hi + (i16 >> 2)) * VSTR + (16 * (g4 & 1) + 4 * (i16 & 3)) * 2;
#pragma unroll
            for (int ks = 0; ks < 4; ++ks) {
                const bf16x8 af = cat8(trr(ka + (16 * ks) * QSTR), trr(ka + (16 * ks + 4) * QSTR));
                const bf16x8 b0 = cat8(trr(va + (16 * ks) * VSTR), trr(va + (16 * ks + 4) * VSTR));
                const bf16x8 b1 = cat8(trr(va + (16 * ks) * VSTR + 64), trr(va + (16 * ks + 4) * VSTR + 64));
                ax0 = __builtin_amdgcn_mfma_f32_32x32x16_bf16(af, b0, ax0, 0, 0, 0);
                ax1 = __builtin_amdgcn_mfma_f32_32x32x16_bf16(af, b1, ax1, 0, 0, 0);
            }
            if (wid == 6) { if (c < 64) ML_GATES(c + 1, gnxt); }
            if (wid == 7) {
                float a0 = 0.f, a1 = 0.f;
                for (int s = 0; s < 64; ++s) { const unsigned w = *(const LAS unsigned*)(L + L_KS + s * QSTR + lane * 4); const float was = gcur[G_WA + s]; a0 += was * bflo(w); a1 += was * bfhi(w); }
                nnxt[2 * lane] = wc_ * ncur[2 * lane] + a0; nnxt[2 * lane + 1] = wc_ * ncur[2 * lane + 1] + a1;
            }
        }
        __syncthreads();
        if (wid >= 4) {
            const int db = wid - 4;
#pragma unroll
            for (int g = 0; g < 4; ++g) {
                unsigned long long w0 = (unsigned long long)cvtpk(ax0[4 * g], ax0[4 * g + 1]) | ((unsigned long long)cvtpk(ax0[4 * g + 2], ax0[4 * g + 3]) << 32);
                unsigned long long w1 = (unsigned long long)cvtpk(ax1[4 * g], ax1[4 * g + 1]) | ((unsigned long long)cvtpk(ax1[4 * g + 2], ax1[4 * g + 3]) << 32);
                *(LAS unsigned long long*)(L + L_XT + r32 * QSTR + (32 * db + 8 * g + 4 * hi) * 2) = w0;
                *(LAS unsigned long long*)(L + L_XT + (32 + r32) * QSTR + (32 * db + 8 * g + 4 * hi) * 2) = w1;
            }
        }
        if (c < 64) ML_STAGE(gnxt);
        __syncthreads();
    }
#undef ML_PREFETCH
#undef ML_STAGE
#undef ML_GATES
}
}

namespace at {
using bf16x8 = ml::bf16x8; using f32x16 = ml::f32x16;
constexpr int KSTR = 144;
constexpr int A_K = 0, A_V = 288 * KSTR, A_ST = A_V + 288 * 128, A_SCR = A_ST + 8 * 32 * 36 * 4, A_END = A_SCR + 8 * 32 * 4;
static_assert(A_END <= RING_BYTES, "attention LDS map");
__device__ __forceinline__ void attn_unit(Frame& F, int unit) {
    const int b = unit >> 7, rem = unit & 127, qblk = rem >> 2, kvh = rem & 3;
    const int tid = F.tid, lane = F.lane, wid = F.wave, r32 = lane & 31, hi = lane >> 5, g4 = lane >> 4, i16 = lane & 15;
    LAS unsigned char* L = F.lds + RING_OFF;
    __syncthreads();
    for (int c = tid; c < 288 * 8; c += NWAVES * 64) {
        const int j = c >> 3, pc = c & 7;
        long row = -1;
        if (j < 16) row = MR + j;
        else if (j >= 32) { const int sidx = qblk * 128 - 128 + (j - 32); if (sidx >= 0) row = (long)b * SEQ + sidx; }
        v4u kq = {0u, 0u, 0u, 0u}, vq = {0u, 0u, 0u, 0u};
        if (row >= 0) { const bf16* p = F.KV + (size_t)row * 512 + kvh * 64 + pc * 8; kq = *(const GAS v4u*)p; vq = *(const GAS v4u*)(p + 256); }
        *(LAS v4u*)(L + A_K + j * KSTR + pc * 16) = kq;
        *(LAS v4u*)(L + A_V + ((j >> 3) * 2 + (pc >> 2)) * 512 + (j & 7) * 64 + (pc & 3) * 16) = vq;
    }
    __syncthreads();
    const int g = wid >> 1, qh = wid & 1, head = kvh * 4 + g;
    const float sink2 = F.sinks[head] * 1.4426950408889634f;
    LAS float* SCR = (LAS float*)(L + A_SCR) + wid * 32;
    LAS float* ST = (LAS float*)(L + A_ST) + wid * (32 * 36);
    const float NEG = -INFINITY;
#pragma unroll 1
    for (int blk = 0; blk < 2; ++blk) {
        const int q0 = 64 * qh + 32 * blk, T0 = q0 >> 5;
        const size_t grow0 = (size_t)b * SEQ + qblk * 128 + q0;
        bf16x8 qf[4];
        { const bf16* qp = F.Q + (grow0 + r32) * DM + head * 64 + 8 * hi;
#pragma unroll
          for (int kk = 0; kk < 4; ++kk) qf[kk] = *(const GAS bf16x8*)(qp + 16 * kk); }
        f32x16 S[6];
#pragma unroll
        for (int ti = 0; ti < 6; ++ti) {
            const int lrow0 = (ti == 0) ? 0 : 32 + 32 * (T0 + ti - 1);
            const LAS unsigned char* krow = L + A_K + (lrow0 + r32) * KSTR + hi * 16;
#pragma unroll
            for (int r = 0; r < 16; ++r) S[ti][r] = 0.f;
#pragma unroll
            for (int kk = 0; kk < 4; ++kk) S[ti] = __builtin_amdgcn_mfma_f32_32x32x16_bf16(*(const LAS bf16x8*)(krow + kk * 32), qf[kk], S[ti], 0, 0, 0);
        }
        float mx = sink2;
#pragma unroll
        for (int ti = 0; ti < 6; ++ti) {
            const bool dead = (ti >= 1) && (qblk == 0) && (T0 + ti - 1 < 4);
#pragma unroll
            for (int r = 0; r < 16; ++r) {
                const int kl = ml::crow(r, hi);
                bool valid;
                if (ti == 0) valid = kl < 16;
                else if (ti == 1) valid = (kl > r32) && !dead;
                else if (ti == 5) valid = (kl <= r32);
                else valid = !dead;
                const float v = valid ? S[ti][r] : NEG;
                S[ti][r] = v; mx = fmaxf(mx, v);
            }
        }
        mx = fmaxf(mx, __shfl_xor(mx, 32));
        float l = 0.f;
#pragma unroll
        for (int ti = 0; ti < 6; ++ti)
#pragma unroll
            for (int r = 0; r < 16; ++r) { const float p = __builtin_amdgcn_exp2f(S[ti][r] - mx); S[ti][r] = p; l += p; }
        l += __shfl_xor(l, 32);
        l += __builtin_amdgcn_exp2f(sink2 - mx);
        SCR[r32] = 1.0f / l;
        f32x16 O0, O1;
#pragma unroll
        for (int r = 0; r < 16; ++r) { O0[r] = 0.f; O1[r] = 0.f; }
        const LAS unsigned char* vbase = L + A_V + (4 * hi + (i16 >> 2)) * 64 + 32 * (g4 & 1) + 8 * (i16 & 3);
#pragma unroll
        for (int ti = 0; ti < 6; ++ti) {
            const int lrow0 = (ti == 0) ? 0 : 32 + 32 * (T0 + ti - 1);
#pragma unroll
            for (int ks = 0; ks < 2; ++ks) {
                u32x4_t a; a.x = ml::cvtpk(S[ti][8 * ks + 0], S[ti][8 * ks + 1]); a.y = ml::cvtpk(S[ti][8 * ks + 2], S[ti][8 * ks + 3]);
                a.z = ml::cvtpk(S[ti][8 * ks + 4], S[ti][8 * ks + 5]); a.w = ml::cvtpk(S[ti][8 * ks + 6], S[ti][8 * ks + 7]);
                const LAS unsigned char* vp = vbase + (((lrow0 >> 3) + 2 * ks) * 2) * 512;
                const bf16x8 b0 = ml::cat8(ml::trr(vp), ml::trr(vp + 1024));
                const bf16x8 b1 = ml::cat8(ml::trr(vp + 512), ml::trr(vp + 1024 + 512));
                O0 = __builtin_amdgcn_mfma_f32_32x32x16_bf16(__builtin_bit_cast(bf16x8, a), b0, O0, 0, 0, 0);
                O1 = __builtin_amdgcn_mfma_f32_32x32x16_bf16(__builtin_bit_cast(bf16x8, a), b1, O1, 0, 0, 0);
            }
        }
        f32x4 rd4[4];
#pragma unroll
        for (int gq = 0; gq < 4; ++gq) rd4[gq] = *(const LAS f32x4*)(SCR + 8 * gq + 4 * hi);
#pragma unroll
        for (int dblk = 0; dblk < 2; ++dblk) {
#pragma unroll
            for (int r = 0; r < 16; ++r) ST[ml::crow(r, hi) * 36 + r32] = (dblk == 0 ? O0[r] : O1[r]) * rd4[r >> 2][r & 3];
#pragma unroll
            for (int i = 0; i < 4; ++i) {
                const int idx = lane + 64 * i, q = idx >> 3, p = idx & 7;
                const f32x4 o4 = *(const LAS f32x4*)(ST + q * 36 + 4 * p);
                const size_t off = (grow0 + q) * DM + head * 64 + 32 * dblk + 4 * p;
                const unsigned long long z = *(const GAS unsigned long long*)(F.AZ + off);
                const unsigned lo = ml::cvtpk(o4[0] * bflo((unsigned)z), o4[1] * bfhi((unsigned)z)), hi2 = ml::cvtpk(o4[2] * bflo((unsigned)(z >> 32)), o4[3] * bfhi((unsigned)(z >> 32)));
                *(GAS unsigned long long*)(F.Q + off) = (unsigned long long)lo | ((unsigned long long)hi2 << 32);
            }
        }
    }
}
}


__device__ __forceinline__ void p3_min(Frame& F) {
    const int gw = F.vcu * NWAVES + F.wave, NGW = F.G * NWAVES, lane = F.lane;
    for (int m = gw; m < MR; m += NGW) {
#pragma unroll
        for (int hh = 0; hh < 4; ++hh) {
            const size_t off = (size_t)m * DM + hh * 256 + 4 * lane;
            const unsigned long long cw = *(const GAS unsigned long long*)(F.MV + off), ow = *(const GAS unsigned long long*)(F.MO + off), zw = *(const GAS unsigned long long*)(F.MZ + off);
            const f32x4 gm = *(const f32x4*)(F.head_norm + hh * 256 + 4 * lane);
            float xv[4];
            xv[0] = bflo((unsigned)cw) * bflo((unsigned)ow); xv[1] = bfhi((unsigned)cw) * bfhi((unsigned)ow);
            xv[2] = bflo((unsigned)(cw >> 32)) * bflo((unsigned)(ow >> 32)); xv[3] = bfhi((unsigned)(cw >> 32)) * bfhi((unsigned)(ow >> 32));
            const float mu = wave_sum((xv[0] + xv[1]) + (xv[2] + xv[3])) * (1.f / 256.f);
            float q = 0.f;
#pragma unroll
            for (int e = 0; e < 4; ++e) { xv[e] -= mu; q += xv[e] * xv[e]; }
            const float rstd = 1.0f / sqrtf(wave_sum(q) * (1.f / 256.f) + LN_EPS);
            const float z0 = bflo((unsigned)zw), z1 = bfhi((unsigned)zw), z2 = bflo((unsigned)(zw >> 32)), z3 = bfhi((unsigned)(zw >> 32));
            const unsigned lo = pk2(xv[0] * rstd * gm[0] * z0, xv[1] * rstd * gm[1] * z1), hi = pk2(xv[2] * rstd * gm[2] * z2, xv[3] * rstd * gm[3] * z3);
            *(GAS unsigned long long*)(F.MV + off) = (unsigned long long)lo | ((unsigned long long)hi << 32);
        }
    }
}
__device__ __forceinline__ void p7_final(Frame& F) {
    const int gw = F.vcu * NWAVES + F.wave, NGW = F.G * NWAVES, lane = F.lane;
    f32x4 gp[4];
#pragma unroll
    for (int j = 0; j < 4; ++j) gp[j] = *(const f32x4*)(F.norm_post + 256 * j + 4 * lane);
    for (int m = gw; m < MR; m += NGW) {
        const GAS f32x4* yr = (const GAS f32x4*)(F.OUTF + (size_t)m * DM) + lane;
        const GAS f32x4* xr = (const GAS f32x4*)(F.x + (size_t)m * DM) + lane;
        GAS f32x4* orow = (GAS f32x4*)(F.out + (size_t)m * DM) + lane;
        f32x4 v[4], xv[4]; float s = 0.f;
#pragma unroll
        for (int j = 0; j < 4; ++j) { v[j] = yr[64 * j]; xv[j] = xr[64 * j]; s += (v[j].x * v[j].x + v[j].y * v[j].y) + (v[j].z * v[j].z + v[j].w * v[j].w); }
        const float rstd = 1.0f / sqrtf(wave_sum(s) * (1.f / DM) + RMS_EPS);
#pragma unroll
        for (int j = 0; j < 4; ++j) orow[64 * j] = xv[j] + v[j] * rstd * gp[j];
    }
}

struct Args { const float* in[13]; float* out; unsigned char* ws; int ph_lo, ph_hi, li, pad; };
__global__ void __launch_bounds__(NWAVES * 64, 2) hyb_fwd(Args args) {
    extern __shared__ __attribute__((aligned(16))) unsigned char lds[];
    Frame F;
    F.lds = (LAS unsigned char*)lds;
    F.MISC = (volatile LAS unsigned*)(F.lds + MISC_OFF);
    F.tid = threadIdx.x; F.lane = F.tid & 63; F.wave = __builtin_amdgcn_readfirstlane(F.tid >> 6);
    F.G = gridDim.x; { const int bx = blockIdx.x; F.vcu = (F.G % 8 == 0) ? (bx % 8) * (F.G / 8) + bx / 8 : bx; }
    unsigned char* ws = args.ws;
    F.ctl = (gu32*)(ws + WS_CTL);
    F.x = args.in[0]; F.meta = args.in[1]; F.norm_pre = args.in[2]; F.w_in = args.in[3]; F.sinks = args.in[4]; F.conv_w = args.in[5]; F.conv_b = args.in[6];
    F.gate_bias = args.in[7]; F.head_norm = args.in[8]; F.w_ao = args.in[9]; F.w_mo = args.in[10]; F.w_out = args.in[11]; F.norm_post = args.in[12];
    F.out = args.out;
    F.W1T = (bf16*)(ws + WS_W1T); F.WAO = (bf16*)(ws + WS_WAO); F.WMO = (bf16*)(ws + WS_WMO); F.WOUT = (bf16*)(ws + WS_WOUT);
    F.ROPE = (float*)(ws + WS_ROPE); F.IF = (float*)(ws + WS_IF); F.OUTF = (float*)(ws + WS_OUTF);
    F.U = (bf16*)(ws + WS_U); F.KV = (bf16*)(ws + WS_KV); F.MQK = (bf16*)(ws + WS_MQK); F.MV = (bf16*)(ws + WS_MV); F.Q = (bf16*)(ws + WS_Q);
    F.AZ = (bf16*)(ws + WS_AZ); F.MO = (bf16*)(ws + WS_MO); F.MZ = (bf16*)(ws + WS_MZ);
    F.GA = (bf16*)args.out; F.GM = (bf16*)args.out + (size_t)MR * DM;
    for (int u = F.tid; u < (LDS_BYTES - LDSCTL_OFF) / 4; u += NWAVES * 64) ((LAS unsigned*)(F.lds + LDSCTL_OFF))[u] = 0u;
    __syncthreads();
    XcdBarrier bar; bar.bar = (unsigned*)(F.ctl + CW_BAR); bar.x = 0; bar.st = nullptr;
    if (N_LAUNCHES == 1) bar = xcd_barrier_post((unsigned*)(F.ctl + CW_BAR), F.MISC + 8);
#define GRID_BAR() do { if (N_LAUNCHES == 1) xcd_barrier(bar); } while (0)
    const int lo = args.ph_lo, hi = args.ph_hi;
#define IN(k) (lo <= (k) && (k) < hi)
#define BOTH(k) (IN(k) && IN((k) + 1))

    if (IN(0)) { p0_prologue(F); if (BOTH(0)) GRID_BAR(); }

    if (IN(1)) {
        pg8::Gemm g{F.U, F.W1T, MT, NIN, DM}; pg8::StaticOrder S; S.init(MT, NIN, F.G, (int)blockIdx.x);
        pg8::EpiInProj E{args.ws, (unsigned char*)args.out, F.ROPE};
        static_assert(WS_Q == 484 * MiB && WS_KV == 161 * MiB && WS_AZ == 612 * MiB && WS_MQK == 226 * MiB && WS_MV == 355 * MiB && WS_MO == 740 * MiB && WS_MZ == 868 * MiB, "EpiInProj offsets");
        pg8::gemm_phase<pg8::EpiInProj, pg8::StaticOrder, true, true>(F.lds + RING_OFF, g, S, E);
        if (BOTH(1)) GRID_BAR();
    }

    if (IN(2)) {
        conv_prepass(F);
        for (int u = blockIdx.x; u < BATCH * 32 * 4; u += F.G) at::attn_unit(F, u);
        if (BOTH(2)) GRID_BAR();
    }
    if (IN(3)) {
        for (int c = blockIdx.x; c < BATCH * 16; c += F.G) ml::mlstm_chain(F, c);
        if (BOTH(3)) GRID_BAR();
    }

    if (IN(4)) { p3_min(F); if (BOTH(4)) GRID_BAR(); }

    if (IN(5)) {
        pg8::Gemm g{F.Q, F.WAO, MR, DM, DM}; pg8::StaticOrder S; S.init(MR, DM, F.G, (int)blockIdx.x);
        pg8::EpiGate E{F.GA, nullptr, F.AZ};
        pg8::gemm_phase<pg8::EpiGate, pg8::StaticOrder, true, true>(F.lds + RING_OFF, g, S, E);
        if (BOTH(5)) GRID_BAR();
    }
    if (IN(6)) {
        pg8::Gemm g{F.MV, F.WMO, MR, DM, DM}; pg8::StaticOrder S; S.init(MR, DM, F.G, (int)blockIdx.x);
        pg8::EpiGate E{F.GM, F.AZ, F.MQK};
        pg8::gemm_phase<pg8::EpiGate, pg8::StaticOrder, true, true>(F.lds + RING_OFF, g, S, E);
        if (BOTH(6)) GRID_BAR();
    }
    if (IN(7)) {
        pg8::Gemm g{F.MQK, F.WOUT, MR, DM, DM}; pg8::StaticOrder S; S.init(MR, DM, F.G, (int)blockIdx.x);
        pg8::EpiF32 E{F.OUTF, DM};
        pg8::gemm_phase<pg8::EpiF32, pg8::StaticOrder, true, true>(F.lds + RING_OFF, g, S, E);
        if (BOTH(7)) GRID_BAR();
    }
    if (IN(8)) { p7_final(F); }
#undef IN
#undef BOTH
}

extern "C" void kernel_launch(void* const* d_in, const int* in_sizes, int n_in, void* d_out, int out_size, void* d_ws, size_t ws_size, hipStream_t stream) {
    static int grid = 0;
    if (grid == 0) {
        if (n_in != 13 || in_sizes[0] != MR * DM || out_size != MR * DM || ws_size < WS_END) { fprintf(stderr, "kernel_launch: unexpected shapes (n_in %d, in0 %d, out %d, ws %zu); nothing launched\n", n_in, n_in > 0 ? in_sizes[0] : -1, out_size, ws_size); grid = -1; return; }
        int dev = 0, cus = 0, per_cu = 0;
        if (hipGetDevice(&dev) != hipSuccess || hipDeviceGetAttribute(&cus, hipDeviceAttributeMultiprocessorCount, dev) != hipSuccess) { grid = -1; return; }
        if (hipFuncSetAttribute((const void*)hyb_fwd, hipFuncAttributeMaxDynamicSharedMemorySize, LDS_BYTES) != hipSuccess) { fprintf(stderr, "kernel_launch: hipFuncSetAttribute failed\n"); grid = -1; return; }
        if (hipOccupancyMaxActiveBlocksPerMultiprocessor(&per_cu, (const void*)hyb_fwd, NWAVES * 64, LDS_BYTES) != hipSuccess || per_cu < 1)
            fprintf(stderr, "kernel_launch: note: occupancy query reports %d workgroups per CU\n", per_cu);
        (void)hipGetLastError();
        grid = cus;
    }
    if (grid < 0) return;
    if (hipMemsetAsync((char*)d_ws + WS_CTL, 0, CTL_ZERO_BYTES, stream) != hipSuccess) { fprintf(stderr, "kernel_launch: hipMemsetAsync failed\n"); return; }
    Args a{};
    for (int i = 0; i < 13; ++i) a.in[i] = (const float*)d_in[i];
    a.out = (float*)d_out; a.ws = (unsigned char*)d_ws;
    for (int li = 0; li < N_LAUNCHES; ++li) {
        a.ph_lo = (N_LAUNCHES == 1) ? 0 : li; a.ph_hi = (N_LAUNCHES == 1) ? PER_PHASE : li + 1; a.li = li;
        hipLaunchKernelGGL(hyb_fwd, dim3(grid), dim3(NWAVES * 64), LDS_BYTES, stream, a);
        const hipError_t le = hipPeekAtLastError();
        if (le != hipSuccess) { fprintf(stderr, "kernel_launch: launch %d failed: %s\n", li, hipGetErrorName(le)); break; }
    }
}
```
